# Optimizing an MI355X kernel written in HIP

```python
import jax, jax.numpy as jnp
from jax import lax
import numpy as np

D_MODEL = 1024
BATCH = 8
SEQ = 4096
DEPTH = 1

CHUNK = 64
N_META = 16

POOL_WIDTH = 512
POOL_WINDOWS = (2, 4, 8, 16)
POOL_GROUPS = len(POOL_WINDOWS)
POOL_GROUP_DIM = POOL_WIDTH // POOL_GROUPS
POOL_OUT_DIM = D_MODEL // POOL_GROUPS

CONV_WIDTH = 512
CONV_KERNEL = 31

N_BRANCHES = 2
IN_COLS = POOL_WIDTH + 2 * CONV_WIDTH + N_BRANCHES * D_MODEL

N_EXPERTS = 32
TOP_K = 4
D_EXPERT = D_MODEL
SWIGLU_LIMIT = 7.0
SWIGLU_ALPHA = 1.702
MOE_BLOCK = 256

RMS_EPS = 1e-5
LN_EPS = 1e-5

kernel_name = "hybrid_pool_conformerconv_moe_block"


def rmsnorm(x, g):
    xf = x.astype(jnp.float32)
    y = xf * lax.rsqrt(jnp.mean(xf * xf, axis=-1, keepdims=True) + RMS_EPS)
    return (y * g.astype(jnp.float32)).astype(x.dtype)


def pool_mixer(u, w_grp, scale):
    b, l, _ = u.shape
    uf = u.astype(jnp.float32)
    cs = jnp.cumsum(uf, axis=1)
    t = jnp.arange(1, l + 1, dtype=jnp.float32)[None, :, None]
    outs = []
    for g, w in enumerate(POOL_WINDOWS):
        c = cs[..., g * POOL_GROUP_DIM:(g + 1) * POOL_GROUP_DIM]
        c_prev = jnp.pad(c, ((0, 0), (w, 0), (0, 0)))[:, :l]
        mean = (c - c_prev) / jnp.minimum(t, float(w))
        outs.append(mean - uf[..., g * POOL_GROUP_DIM:(g + 1) * POOL_GROUP_DIM])
    d = jnp.stack(outs, axis=2).astype(u.dtype)
    y = jnp.einsum('blgc,gcd->blgd', d, w_grp).reshape(b, l, D_MODEL)
    return y * scale


def conformer_conv(v, gt, k_dw, b_dw, ln_g, ln_b, w_pw2, b_pw2):
    a = v * jax.nn.sigmoid(gt)
    c = lax.conv_general_dilated(
        a, k_dw[:, None, :], window_strides=(1,),
        padding=[(CONV_KERNEL - 1, 0)],
        dimension_numbers=('NWC', 'WIO', 'NWC'),
        feature_group_count=CONV_WIDTH) + b_dw
    cf = c.astype(jnp.float32)
    mu = jnp.mean(cf, axis=-1, keepdims=True)
    var = jnp.mean(jnp.square(cf - mu), axis=-1, keepdims=True)
    cn = ((cf - mu) * lax.rsqrt(var + LN_EPS) * ln_g.astype(jnp.float32)
          + ln_b.astype(jnp.float32)).astype(v.dtype)
    return jax.nn.silu(cn) @ w_pw2 + b_pw2


def moe_ffn(h, router_w, router_b, w_gu, b_gu, w_dn, b_dn):
    n_tok = h.shape[0]
    logits = h.astype(jnp.float32) @ router_w.astype(jnp.float32) + router_b.astype(jnp.float32)
    top_v, top_i = lax.top_k(logits, TOP_K)
    gates = jax.nn.softmax(top_v, axis=-1)

    n_assign = n_tok * TOP_K
    e_flat = top_i.reshape(-1)
    tok_flat = jnp.arange(n_assign, dtype=jnp.int32) // TOP_K
    g_flat = gates.reshape(-1)
    order = jnp.argsort(e_flat)
    se, stok, sg = e_flat[order], tok_flat[order], g_flat[order]

    counts = jnp.bincount(e_flat, length=N_EXPERTS)
    padded = (counts + MOE_BLOCK - 1) // MOE_BLOCK * MOE_BLOCK
    start = jnp.cumsum(counts) - counts
    pend = jnp.cumsum(padded)
    pstart = pend - padded
    dest = pstart[se] + jnp.arange(n_assign, dtype=jnp.int32) - start[se]

    n_blocks = -(-n_assign // MOE_BLOCK) + N_EXPERTS
    n_slots = n_blocks * MOE_BLOCK
    slot_tok = jnp.zeros((n_slots,), jnp.int32).at[dest].set(stok)
    slot_g = jnp.zeros((n_slots,), jnp.float32).at[dest].set(sg)
    block_e = jnp.minimum(
        jnp.searchsorted(pend, jnp.arange(n_blocks, dtype=pend.dtype) * MOE_BLOCK, side='right'),
        N_EXPERTS - 1)

    def expert_block(args):
        idx, gw, e = args
        xb = h[idx]
        gu = xb @ w_gu[e] + b_gu[e]
        gate, up = gu[:, :D_EXPERT], gu[:, D_EXPERT:]
        gate = jnp.minimum(gate, SWIGLU_LIMIT)
        up = jnp.clip(up, -SWIGLU_LIMIT, SWIGLU_LIMIT)
        act = (up + 1.0) * (gate * jax.nn.sigmoid(gate * SWIGLU_ALPHA))
        y = act @ w_dn[e] + b_dn[e]
        return y * gw[:, None].astype(y.dtype)

    y = lax.map(expert_block, (slot_tok.reshape(n_blocks, MOE_BLOCK),
                               slot_g.reshape(n_blocks, MOE_BLOCK), block_e))
    return jax.ops.segment_sum(y.reshape(n_slots, D_MODEL), slot_tok, num_segments=n_tok)


def setup_inputs(seed: int = 0) -> dict:
    key = jax.random.key(seed)
    ks = jax.random.split(key, 24)
    f32 = jnp.float32
    n = lambda k, s, sc: jax.random.normal(k, s, f32) * sc
    L_ = DEPTH
    return {
        "x": n(ks[0], (BATCH, SEQ, D_MODEL), 1.0),
        "meta_tokens": n(ks[1], (N_META, D_MODEL), 1.0),
        "norm_mix_g": 1.0 + n(ks[2], (L_, D_MODEL), 0.05),
        "w_in": n(ks[3], (L_, D_MODEL, IN_COLS), D_MODEL ** -0.5),
        "b_in": n(ks[4], (L_, IN_COLS), 0.02),
        "w_pool_grp": n(ks[5], (L_, POOL_GROUPS, POOL_GROUP_DIM, POOL_OUT_DIM), POOL_GROUP_DIM ** -0.5),
        "pool_scale": 1.0 + n(ks[6], (L_, D_MODEL), 0.1),
        "w_dwconv": n(ks[7], (L_, CONV_KERNEL, CONV_WIDTH), CONV_KERNEL ** -0.5),
        "b_dwconv": n(ks[8], (L_, CONV_WIDTH), 0.02),
        "conv_ln_g": 1.0 + n(ks[9], (L_, CONV_WIDTH), 0.05),
        "conv_ln_b": n(ks[10], (L_, CONV_WIDTH), 0.02),
        "w_pw2": n(ks[11], (L_, CONV_WIDTH, D_MODEL), CONV_WIDTH ** -0.5),
        "b_pw2": n(ks[12], (L_, D_MODEL), 0.02),
        "w_out": n(ks[13], (L_, D_MODEL, D_MODEL), D_MODEL ** -0.5),
        "norm_ffn_g": 1.0 + n(ks[14], (L_, D_MODEL), 0.05),
        "router_w": n(ks[15], (L_, D_MODEL, N_EXPERTS), D_MODEL ** -0.5),
        "router_b": n(ks[16], (L_, N_EXPERTS), 0.01),
        "w_gate_up": n(ks[17], (L_, N_EXPERTS, D_MODEL, 2 * D_EXPERT), D_MODEL ** -0.5),
        "b_gate_up": n(ks[18], (L_, N_EXPERTS, 2 * D_EXPERT), 0.02),
        "w_down": n(ks[19], (L_, N_EXPERTS, D_EXPERT, D_MODEL), D_EXPERT ** -0.5),
        "b_down": n(ks[20], (L_, N_EXPERTS, D_MODEL), 0.02),
        "norm_final_g": 1.0 + n(ks[21], (D_MODEL,), 0.05),
    }


def reference(x, meta_tokens, norm_mix_g, w_in, b_in, w_pool_grp, pool_scale,
              w_dwconv, b_dwconv, conv_ln_g, conv_ln_b, w_pw2, b_pw2, w_out,
              norm_ffn_g, router_w, router_b, w_gate_up, b_gate_up, w_down, b_down,
              norm_final_g):
    bsz, seq, d = x.shape
    meta = jnp.broadcast_to(meta_tokens[None].astype(x.dtype), (bsz, N_META, d))
    h = jnp.concatenate([meta, x], axis=1)
    length = seq + N_META
    c0 = POOL_WIDTH
    c1 = c0 + CONV_WIDTH
    c2 = c1 + CONV_WIDTH
    c3 = c2 + D_MODEL
    for l in range(DEPTH):
        xn = rmsnorm(h, norm_mix_g[l])
        proj = xn @ w_in[l] + b_in[l]
        u = proj[..., :c0]
        v = proj[..., c0:c1]
        gt = proj[..., c1:c2]
        g_a = proj[..., c2:c3]
        g_b = proj[..., c3:]
        y_a = pool_mixer(u, w_pool_grp[l], pool_scale[l])
        y_b = conformer_conv(v, gt, w_dwconv[l], b_dwconv[l], conv_ln_g[l], conv_ln_b[l],
                             w_pw2[l], b_pw2[l])
        mixed = jax.nn.sigmoid(g_a) * y_a + jax.nn.sigmoid(g_b) * y_b
        h = h + mixed @ w_out[l]
        hn = rmsnorm(h, norm_ffn_g[l]).reshape(bsz * length, d)
        h = h + moe_ffn(hn, router_w[l], router_b[l], w_gate_up[l], b_gate_up[l],
                        w_down[l], b_down[l]).reshape(bsz, length, d)
    h = rmsnorm(h, norm_final_g)
    return h[:, N_META:]
```

```cpp
#include <hip/hip_runtime.h>
#include <hip/hip_cooperative_groups.h>
#include <cstdio>
#include <cstdint>
namespace cg = cooperative_groups;

#define GAS __attribute__((address_space(1)))
#define LAS __attribute__((address_space(3)))
typedef unsigned short bf16_t;
typedef short bf16x8 __attribute__((ext_vector_type(8)));
typedef float f32x4 __attribute__((ext_vector_type(4)));
typedef float f32x16 __attribute__((ext_vector_type(16)));
typedef unsigned u32x4 __attribute__((ext_vector_type(4)));
typedef unsigned u32x2 __attribute__((ext_vector_type(2)));
typedef int i32x4 __attribute__((ext_vector_type(4)));

constexpr int NB = 8, SEQ = 4096, D = 1024, NTOK = NB * SEQ;
constexpr int NMETA = 16, PW = 512, CW = 512, NCOL1 = 3584, CK = 31;
constexpr int NE = 32, TOPK = 4, DE = 1024;
constexpr int NASSIGN = NTOK * TOPK, MAXTILES = NASSIGN / 256 + NE, NSLOT = MAXTILES * 256;
constexpr int CAP = 8192, ESTRIDE = CAP + 256, NSLOTX = NE * ESTRIDE;
constexpr int CTL_CURSOR = 64, CTL_CSTRIDE = 64, CTL_OVF = 32;
#ifndef MK_FORCE_OVF
#define MK_FORCE_OVF 0
#endif
constexpr float RMS_EPS = 1e-5f, LN_EPS = 1e-5f, SW_LIMIT = 7.0f, SW_ALPHA = 1.702f;
constexpr int NWAVES = 8, NTHREADS = 512;
constexpr int LDS_BYTES = 163840;
constexpr int LDS_TILEE_OFF = 131072, LDS_EPI_OFF = 135168, LDS_EPI_BUF = 2048, LDS_NTILES_OFF = LDS_TILEE_OFF + 4 * 600;
#ifndef MK_FP8
#define MK_FP8 1
#endif
constexpr float F8_SA = 16.0f, F8_SW = 1024.0f, F8_SACT = 4.0f, F8_SY = 32.0f;

constexpr size_t MiB = 1u << 20;
constexpr size_t WS_CTL = 0, CTL_ZERO_BYTES = 1 * MiB;
constexpr size_t WS_MISC = 1 * MiB;
constexpr size_t M_RINV1 = 0, M_RINV2 = 131072, M_METAP = 262144, M_METAR = 1048576, M_UMETA = 1048832, M_AMETA = 1065216, M_CNT = 1081600,
                 M_PSTART = 1114368, M_TILEE = 1114624, M_NTILES = 1116928, M_TOPI = 1117184, M_GATE = 1641472, M_TOKSLOT = 2165760,
                 M_SLOTTOK = 2690048, M_SLOTGATE = 3247104, M_SLOTRS = 3804160, M_END = 4361216;
constexpr size_t M_WRT = 5 * MiB;
static_assert(M_END <= M_WRT && M_WRT + 2 * 32 * 1024 * 2 <= 8 * MiB, "misc");
constexpr size_t WS_W1T = 9 * MiB, WS_WPT = 16 * MiB, WS_PW2T = 16 * MiB + 512 * 1024, WS_OUTT = 18 * MiB, WS_GUT = 20 * MiB, WS_DNT = 148 * MiB;
constexpr size_t WS_H1 = 212 * MiB;
constexpr size_t WS_SLOTTOK = 276 * MiB, WS_SLOTGATE = 278 * MiB, WS_SLOTRS = 280 * MiB;
constexpr size_t WS_METAP = WS_H1;
constexpr size_t WS_R1 = 340 * MiB;
constexpr size_t WS_XB = WS_R1, WS_U = WS_R1 + 64 * MiB, WS_A = WS_R1 + 96 * MiB, WS_GA = WS_R1 + 128 * MiB, WS_GB = WS_R1 + 192 * MiB, WS_DP = WS_R1 + 256 * MiB, WS_SC = WS_R1 + 288 * MiB;
constexpr size_t WS_ACT = WS_R1;
constexpr size_t WS_R2 = 660 * MiB;
constexpr size_t WS_MIXED = WS_R2, WS_H1B = WS_R2 + 64 * MiB;
constexpr size_t WS_XQ8 = WS_R2 + 128 * MiB;
constexpr size_t WS_W1G8 = WS_W1T + (size_t)1536 * D * 2;
constexpr size_t WS_YC = WS_R2;
constexpr size_t WS_END = 932 * MiB;
static_assert(WS_SC == WS_DP + 32 * MiB && WS_PW2T + (size_t)D * 640 * 2 > WS_WPT + (size_t)D * 640 * 2 - 1, "combined buffers");
static_assert(MK_FP8 && WS_ACT + (size_t)NSLOTX * 1024 <= WS_R2 && WS_YC + (size_t)NSLOTX * 1024 <= WS_END && NSLOT <= NSLOTX && WS_SLOTRS + (size_t)NSLOTX * 4 <= WS_R1, "ws map");

#define LDS_WAIT() asm volatile("s_waitcnt lgkmcnt(0)" ::: "memory")
#define VM_WAIT() asm volatile("s_waitcnt vmcnt(0)" ::: "memory")
typedef __bf16 bf16v2_t __attribute__((ext_vector_type(2)));
typedef float f32v2_t __attribute__((ext_vector_type(2)));
__device__ __forceinline__ unsigned cvt_pk_bf16(float lo, float hi) { const f32v2_t f = {lo, hi}; const bf16v2_t b = __builtin_convertvector(f, bf16v2_t); return __builtin_bit_cast(unsigned, b); }
__device__ __forceinline__ float bf_lo(unsigned w) { return __uint_as_float(w << 16); }
__device__ __forceinline__ float bf_hi(unsigned w) { return __uint_as_float(w & 0xffff0000u); }
__device__ __forceinline__ float sigmoidf_(float x) { return __builtin_amdgcn_rcpf(1.0f + __builtin_amdgcn_exp2f(x * -1.44269504f)); }
__device__ __forceinline__ float wave_sum(float v) {
#pragma unroll
    for (int o = 1; o < 64; o <<= 1) v += __shfl_xor(v, o);
    return v;
}
__device__ __forceinline__ float clamp448(float v) { return fminf(fmaxf(v, -448.0f), 448.0f); }
__device__ __forceinline__ unsigned pack4_fp8(float a, float b, float c, float d) { int w = __builtin_amdgcn_cvt_pk_fp8_f32(clamp448(a), clamp448(b), 0, false); w = __builtin_amdgcn_cvt_pk_fp8_f32(clamp448(c), clamp448(d), w, true); return (unsigned)w; }
__device__ __forceinline__ unsigned pack4_fp8_nc(float a, float b, float c, float d) { int w = __builtin_amdgcn_cvt_pk_fp8_f32(a, b, 0, false); w = __builtin_amdgcn_cvt_pk_fp8_f32(c, d, w, true); return (unsigned)w; }
__device__ __forceinline__ u32x2 pack8_fp8_nc(const f32x4 a, const f32x4 b, float sc) { u32x2 w; w.x = pack4_fp8_nc(a[0] * sc, a[1] * sc, a[2] * sc, a[3] * sc); w.y = pack4_fp8_nc(b[0] * sc, b[1] * sc, b[2] * sc, b[3] * sc); return w; }
__device__ __forceinline__ u32x2 pack8_fp8(const f32x4 a, const f32x4 b, float sc) { u32x2 w; w.x = pack4_fp8(a[0] * sc, a[1] * sc, a[2] * sc, a[3] * sc); w.y = pack4_fp8(b[0] * sc, b[1] * sc, b[2] * sc, b[3] * sc); return w; }
__device__ __forceinline__ unsigned pack4_u8(const f32x4 a) {
    const unsigned b0 = (unsigned)(a[0] * 255.0f + 0.5f), b1 = (unsigned)(a[1] * 255.0f + 0.5f), b2 = (unsigned)(a[2] * 255.0f + 0.5f), b3 = (unsigned)(a[3] * 255.0f + 0.5f);
    return b0 | (b1 << 8) | (b2 << 16) | (b3 << 24); }
__device__ __forceinline__ f32x4 unpack4_u8(unsigned w) { return (f32x4){(float)(w & 0xffu), (float)((w >> 8) & 0xffu), (float)((w >> 16) & 0xffu), (float)(w >> 24)} * (1.0f / 255.0f); }
__device__ __forceinline__ u32x4 widen_pair(const u32x2 pa, const u32x2 pb, const int fq) {
    const bool odd = (fq & 1) != 0; const u32x2 send = odd ? pa : pb, keep = odd ? pb : pa;
    u32x2 got; got.x = (unsigned)__shfl_xor((int)send.x, 16); got.y = (unsigned)__shfl_xor((int)send.y, 16);
    return odd ? (u32x4){got.x, got.y, keep.x, keep.y} : (u32x4){keep.x, keep.y, got.x, got.y};
}
__device__ __forceinline__ u32x4 pack8(const f32x4 a, const f32x4 b) { u32x4 w; w.x = cvt_pk_bf16(a[0], a[1]); w.y = cvt_pk_bf16(a[2], a[3]); w.z = cvt_pk_bf16(b[0], b[1]); w.w = cvt_pk_bf16(b[2], b[3]); return w; }
__device__ __forceinline__ void unpack8(const u32x4 w, f32x4& a, f32x4& b) { a = (f32x4){bf_lo(w.x), bf_hi(w.x), bf_lo(w.y), bf_hi(w.y)}; b = (f32x4){bf_lo(w.z), bf_hi(w.z), bf_lo(w.w), bf_hi(w.w)}; }

#ifndef MK_KROT
#define MK_KROT 50
#endif
#ifndef MK_HALFU
#define MK_HALFU 1
#endif
namespace pg8 {
constexpr int BM = 256, BK = 64, HALF = 128, HTB = HALF * BK * 2, STAGE_BYTES = 8 * HTB, NXCD = 8, WGM = 8;
__host__ __device__ __forceinline__ int lds_byte(int r, int c) { const int st = (r >> 4) * 2 + (c >> 5), rr = r & 15, cc = c & 31, ob = rr * 64 + cc * 2; return st * 1024 + (ob ^ (((ob >> 9) & 1) << 5)); }
__host__ __device__ __forceinline__ void stage_rc(int b, int& R, int& C) { const int st = b / 1024, sb = b % 1024, swz = sb ^ (((sb >> 9) & 1) << 5); R = (st >> 1) * 16 + swz / 64; C = (st & 1) * 32 + (swz % 64) / 2; }
__host__ __device__ __forceinline__ int perm32(int rho) { const int n = rho >> 4, i = rho & 15; return 8 * (i >> 2) + 4 * n + (i & 3); }

struct Unit { int pm, pn, pe, pv, ph; };
typedef int i32x8_t __attribute__((ext_vector_type(8)));
typedef int i32x4_t __attribute__((ext_vector_type(4)));
__device__ __forceinline__ void mfma_fp8(f32x4& c, const i32x8_t a, const i32x8_t b, const int one) {
    asm volatile("v_mfma_scale_f32_16x16x128_f8f6f4 %0, %1, %2, %0, %3, %3 op_sel_hi:[0,0,0]" : "+v"(c) : "v"(a), "v"(b), "v"(one));
}
__device__ __forceinline__ i32x8_t cat8(const bf16x8 a, const bf16x8 b) { const i32x4_t x = __builtin_bit_cast(i32x4_t, a), y = __builtin_bit_cast(i32x4_t, b); return __builtin_shufflevector(x, y, 0, 1, 2, 3, 4, 5, 6, 7); }

struct DenseSched {
    int nM, nN, nwg, G, c; const char* A; const char* B; size_t a_tile, a_pn, b_tile;
    __device__ __forceinline__ void init(int M, int N, int G_, int c_) { nM = M / BM; nN = N / BM; nwg = nM * nN; G = G_; c = c_; }
    __device__ __forceinline__ bool next(int i, Unit& u) const {
        const long L = (long)i * G + c; if (L >= nwg) return false;
        int wgid = (int)L; { const int q = nwg / NXCD, r = nwg % NXCD, xcd = wgid % NXCD, off = wgid / NXCD; wgid = (xcd < r ? xcd * (q + 1) : r * (q + 1) + (xcd - r) * q) + off; }
        const int nig = WGM * nN, gid = wgid / nig, fm = gid * WGM, gsz = (nM - fm) < WGM ? (nM - fm) : WGM;
        u.pm = fm + ((wgid % nig) % gsz); u.pn = (wgid % nig) / gsz; u.ph = 0; return true;
    }
    __device__ __forceinline__ const char* a_ptr(const Unit& u) const { return A + (size_t)u.pm * a_tile + (size_t)u.pn * a_pn; }
    __device__ __forceinline__ const char* b_ptr(const Unit& u) const { return B + (size_t)u.pn * b_tile; }
    __device__ __forceinline__ const int* rows(const Unit&) const { return nullptr; }
    __device__ __forceinline__ size_t a_skip(const Unit& u) const { return (size_t)(384 - 128 * u.pn) * 2; }
    __device__ __forceinline__ int koff(const Unit& u, int nt) const { return 2 * ((u.pm + u.pn) % (nt >> 1)); }
};
struct MoeSched {
    int nunits, npn, G, c; const char* A; const char* B; const int* rows_; const LAS int* tile_e; size_t a_tile, e_bytes, pn_bytes;
    __device__ __forceinline__ bool next(int i, Unit& u) const {
        int wgid, ph = 0;
        if ((G & 7) == 0) {
            const int W = G >> 3, xcd = c & 7, j = c >> 3, q = nunits >> 3, rq = nunits & 7;
            const int qx = q + (xcd < rq ? 1 : 0), start = xcd * q + (xcd < rq ? xcd : rq), Rx = qx / W, rx = qx - Rx * W;
            if (i < Rx) wgid = start + i * W + j;
            else if (i == Rx && rx > 0) {
                if (MK_HALFU && 2 * rx <= W) { if (j >= 2 * rx) return false; wgid = start + Rx * W + (j >> 1); ph = 1 + (j & 1); }
                else { if (j >= rx) return false; wgid = start + Rx * W + j; }
            } else return false;
        } else {
            const long L = (long)i * G + c; if (L >= nunits) return false;
            wgid = (int)L; { const int q = nunits / NXCD, r = nunits % NXCD, xcd = wgid % NXCD, off = wgid / NXCD; wgid = (xcd < r ? xcd * (q + 1) : r * (q + 1) + (xcd - r) * q) + off; }
        }
        u.ph = ph;
        const int ent = __builtin_amdgcn_readfirstlane(tile_e[wgid / npn]);
        u.pm = ent & 2047; u.pe = (ent >> 11) & 31; u.pv = ent >> 16; u.pn = wgid % npn; return true;
    }
    __device__ __forceinline__ const char* a_ptr(const Unit& u) const { return A + (size_t)u.pm * a_tile; }
    __device__ __forceinline__ const char* b_ptr(const Unit& u) const { return B + (size_t)u.pe * e_bytes + (size_t)u.pn * pn_bytes; }
    __device__ __forceinline__ const int* rows(const Unit& u) const { return rows_ + (size_t)u.pm * BM; }
    __device__ __forceinline__ size_t a_skip(const Unit&) const { return 0; }
    __device__ __forceinline__ int koff(const Unit& u, int nt) const { return 2 * (u.pn % (nt >> 1)); }
};

template <class Epi, class Sched, bool GATHER, bool ALIGN_EPI, bool SP2, bool FP8 = false, bool CATK = false, bool EPF = false, bool HALFU = false, bool KROT = false>
__device__ __forceinline__ void gemm_phase(LAS unsigned char* lds, const int K, const int lda, const int ldb, const Sched& S, const Epi& E) {
    const int tid = threadIdx.x, wid = __builtin_amdgcn_readfirstlane(tid >> 6), lane = tid & 63, wr = wid >> 2, wc = wid & 3, fr = lane & 15, fq = lane >> 4;
    const int nt = K / BK;
    int Rr[2], Cc[2]; unsigned voffA[2], voffB[2];
#pragma unroll
    for (int i = 0; i < 2; ++i) { stage_rc(tid * 16 + i * 8192, Rr[i], Cc[i]); const int Rb = (Rr[i] & ~31) + perm32(Rr[i] & 31);
        voffA[i] = (unsigned)(Rr[i] * lda + Cc[i]) * 2u; voffB[i] = (unsigned)(Rb * ldb + Cc[i]) * 2u; }
    const size_t kstep = (size_t)(BK * 2);
    const size_t hstepA = (size_t)HALF * lda * 2, hstepB = (size_t)HALF * ldb * 2;
    const unsigned lda2 = (unsigned)lda * 2u;
    const unsigned ldsw = (unsigned)wid * 1024u;
    const int aoff = lds_byte(wr * 64 + fr, fq * 8), boff = lds_byte(wc * 32 + fr, fq * 8);
#define PG8_SA(b, h) (((b) * 2 + (h)) * HTB)
#define PG8_SB(b, h) ((4 + (b) * 2 + (h)) * HTB)
#define PG8_ST2(bufoff, gbase, o0, o1) do { \
        __builtin_amdgcn_global_load_lds((const unsigned*)((const char*)(gbase) + (o0)), (LAS unsigned*)(lds + (bufoff) + ldsw), 16, 0, 0); \
        __builtin_amdgcn_global_load_lds((const unsigned*)((const char*)(gbase) + (o1)), (LAS unsigned*)(lds + (bufoff) + ldsw + 8192), 16, 0, 0); } while (0)
#define PG8_STB(bufoff, gbase) PG8_ST2(bufoff, gbase, voffB[0], voffB[1])
#define PG8_STA(bufoff, ubase, H, G0, G1) do { if constexpr (GATHER) { PG8_ST2(bufoff, ubase, G0, G1); } else { PG8_ST2(bufoff, (ubase) + (H) * hstepA, voffA[0], voffA[1]); } } while (0)
#define PG8_LDA(dst, b, h) do { _Pragma("unroll") for (int m = 0; m < 4; ++m) _Pragma("unroll") for (int k = 0; k < 2; ++k) dst[m][k] = *(const LAS bf16x8*)(lds + PG8_SA(b, h) + aoff + m * 2048 + k * 1024); } while (0)
#define PG8_LDB(dst, b, h) do { _Pragma("unroll") for (int n = 0; n < 2; ++n) _Pragma("unroll") for (int k = 0; k < 2; ++k) dst[n][k] = *(const LAS bf16x8*)(lds + PG8_SB(b, h) + boff + n * 2048 + k * 1024); } while (0)
#define PG8_MMA(ai, bj, At, Bt) do { __builtin_amdgcn_s_setprio(1); \
        if constexpr (FP8) { _Pragma("unroll") for (int m = 0; m < 4; ++m) _Pragma("unroll") for (int n = 0; n < 2; ++n) \
            mfma_fp8(acc[ai][bj][m][n], cat8(Bt[n][0], Bt[n][1]), cat8(At[m][0], At[m][1]), f8one); } \
        else { _Pragma("unroll") for (int m = 0; m < 4; ++m) _Pragma("unroll") for (int n = 0; n < 2; ++n) _Pragma("unroll") for (int k = 0; k < 2; ++k) \
            acc[ai][bj][m][n] = __builtin_amdgcn_mfma_f32_16x16x32_bf16(Bt[n][k], At[m][k], acc[ai][bj][m][n], 0, 0, 0); } \
        __builtin_amdgcn_s_setprio(0); } while (0)
#define PG8_WAIT_V(n) asm volatile("s_waitcnt vmcnt(" #n ")" ::: "memory")
#define PG8_WAIT_L(n) asm volatile("s_waitcnt lgkmcnt(" #n ")" ::: "memory")
#define PG8_BAR __builtin_amdgcn_s_barrier()
#define PG8_SCHED __builtin_amdgcn_sched_barrier(0)
    Unit cur, nxt; int ui = 0;
    if (!S.next(0, cur)) return;
    f32x4 acc[2][2][4][2];
#pragma unroll
    for (int a = 0; a < 2; ++a)
#pragma unroll
        for (int b = 0; b < 2; ++b)
#pragma unroll
            for (int m = 0; m < 4; ++m)
#pragma unroll
                for (int n = 0; n < 2; ++n) acc[a][b][m][n] = (f32x4){0.f, 0.f, 0.f, 0.f};
    bf16x8 At[4][2], B0[2][2], B1[2][2];
    int f8one = 0x7f7f7f7f; asm volatile("" : "+v"(f8one));
    const char* cA = S.a_ptr(cur); const char* cB = S.b_ptr(cur);
    int co = 0, no = 0; if constexpr (KROT) co = S.koff(cur, nt);
    const char* pA = cA + (size_t)co * kstep; const char* pB = cB + (size_t)co * kstep;
    if constexpr (EPF) E.prefetch(lds + LDS_EPI_OFF, cur, wid, lane);
    unsigned ca00 = 0, ca01 = 0, ca10 = 0, ca11 = 0;
    if constexpr (GATHER) { const int* rw = S.rows(cur); const int pv = cur.pv;
        ca00 = (unsigned)(Rr[0] < pv ? rw[Rr[0]] : 0) * lda2 + Cc[0] * 2; ca01 = (unsigned)(Rr[1] < pv ? rw[Rr[1]] : 0) * lda2 + Cc[1] * 2; ca10 = (unsigned)(HALF + Rr[0] < pv ? rw[HALF + Rr[0]] : 0) * lda2 + Cc[0] * 2; ca11 = (unsigned)(HALF + Rr[1] < pv ? rw[HALF + Rr[1]] : 0) * lda2 + Cc[1] * 2; }
    if constexpr (SP2) {
        PG8_STB(PG8_SB(0, 0), pB); PG8_STB(PG8_SB(0, 1), pB + hstepB); PG8_STA(PG8_SA(0, 0), pA, 0, ca00, ca01); PG8_STA(PG8_SA(0, 1), pA, 1, ca10, ca11);
        if (wr == 1) PG8_BAR;
        PG8_WAIT_V(2); PG8_BAR;
        PG8_STB(PG8_SB(1, 0), pB + kstep); PG8_STA(PG8_SA(1, 0), pA + kstep, 0, ca00, ca01); PG8_STB(PG8_SB(1, 1), pB + hstepB + kstep);
        PG8_WAIT_V(6); PG8_BAR;
    } else {
        PG8_STB(PG8_SB(0, 0), cB); PG8_STA(PG8_SA(0, 0), cA, 0, ca00, ca01); PG8_STB(PG8_SB(0, 1), cB + hstepB); PG8_STA(PG8_SA(0, 1), cA, 1, ca10, ca11);
        if (wr == 1) PG8_BAR;
        PG8_WAIT_V(4); PG8_BAR;
        PG8_STB(PG8_SB(1, 0), cB + kstep); PG8_STA(PG8_SA(1, 0), cA + kstep, 0, ca00, ca01); PG8_STB(PG8_SB(1, 1), cB + hstepB + kstep);
        PG8_WAIT_V(6); PG8_BAR;
    }
    for (;;) {
        const bool has_next = S.next(ui + 1, nxt);
        const char* nA = has_next ? S.a_ptr(nxt) : cA; const char* nB = has_next ? S.b_ptr(nxt) : cB;
        if constexpr (KROT) no = has_next ? S.koff(nxt, nt) : co;
        size_t cskip = 0; if constexpr (CATK) cskip = S.a_skip(cur);
        if constexpr (EPF) { if (has_next) E.prefetch(lds + LDS_EPI_OFF + ((ui + 1) % 3) * LDS_EPI_BUF, nxt, wid, lane); }
        int nr00 = 0, nr01 = 0, nr10 = 0, nr11 = 0;
        int pvn = 0;
        if constexpr (GATHER) { const int* rw = has_next ? S.rows(nxt) : S.rows(cur); pvn = has_next ? nxt.pv : cur.pv; nr00 = rw[Rr[0]]; nr01 = rw[Rr[1]]; nr10 = rw[HALF + Rr[0]]; nr11 = rw[HALF + Rr[1]]; }
        unsigned na00 = ca00, na01 = ca01, na10 = ca10, na11 = ca11;
        const bool do0 = !HALFU || cur.ph != 2, do1 = !HALFU || cur.ph != 1;
        for (int t = 0; t < nt; t += 2) {
            const bool last = (t == nt - 2);
            const int kt = (KROT && t + co >= nt) ? t + co - nt : t + co, kt2 = (KROT && t + 2 + co >= nt) ? t + 2 + co - nt : t + 2 + co;
            const char* a1 = cA + (size_t)(kt + 1) * kstep + ((CATK && t >= 2) ? cskip : 0);
            const char* a2 = last ? nA + (size_t)no * kstep : cA + (size_t)kt2 * kstep + (CATK ? cskip : 0); const char* b2 = last ? nB + (size_t)no * kstep : cB + (size_t)kt2 * kstep;
            const char* a3 = a2 + kstep; const char* b3 = b2 + kstep;
            unsigned s00 = ca00, s01 = ca01, s10 = ca10, s11 = ca11;
            if constexpr (GATHER) { if (last) { na00 = (unsigned)(Rr[0] < pvn ? nr00 : 0) * lda2 + Cc[0] * 2; na01 = (unsigned)(Rr[1] < pvn ? nr01 : 0) * lda2 + Cc[1] * 2; na10 = (unsigned)(HALF + Rr[0] < pvn ? nr10 : 0) * lda2 + Cc[0] * 2; na11 = (unsigned)(HALF + Rr[1] < pvn ? nr11 : 0) * lda2 + Cc[1] * 2;
                                               s00 = na00; s01 = na01; s10 = na10; s11 = na11; } }
            if constexpr (SP2) {
            PG8_LDB(B0, 0, 0); PG8_LDB(B1, 0, 1); PG8_SCHED; PG8_LDA(At, 0, 0); PG8_STA(PG8_SA(1, 1), a1, 1, ca10, ca11);
            PG8_WAIT_V(8); PG8_WAIT_L(0); PG8_BAR; if (do0) { PG8_MMA(0, 0, At, B0); PG8_MMA(0, 1, At, B1); } PG8_BAR; PG8_SCHED;
            PG8_LDA(At, 0, 1); PG8_STB(PG8_SB(0, 0), b2); PG8_STB(PG8_SB(0, 1), b2 + hstepB); PG8_STA(PG8_SA(0, 0), a2, 0, s00, s01);
            PG8_WAIT_V(8); PG8_WAIT_L(0); PG8_BAR; if (do1) { PG8_MMA(1, 0, At, B0); PG8_MMA(1, 1, At, B1); } PG8_BAR; PG8_SCHED;
            PG8_LDB(B0, 1, 0); PG8_LDB(B1, 1, 1); PG8_SCHED; PG8_LDA(At, 1, 0); PG8_STA(PG8_SA(0, 1), a2, 1, s10, s11);
            PG8_WAIT_V(8); PG8_WAIT_L(0); PG8_BAR; if (do0) { PG8_MMA(0, 0, At, B0); PG8_MMA(0, 1, At, B1); } PG8_BAR; PG8_SCHED;
            PG8_LDA(At, 1, 1); PG8_STB(PG8_SB(1, 0), b3); PG8_STB(PG8_SB(1, 1), b3 + hstepB); PG8_STA(PG8_SA(1, 0), a3, 0, s00, s01);
            PG8_WAIT_V(8); PG8_WAIT_L(0); PG8_BAR; if (do1) { PG8_MMA(1, 0, At, B0); PG8_MMA(1, 1, At, B1); } PG8_BAR; PG8_SCHED;
            } else {
            PG8_LDB(B0, 0, 0); PG8_SCHED; PG8_LDA(At, 0, 0); PG8_STA(PG8_SA(1, 1), a1, 1, ca10, ca11);
            PG8_WAIT_L(8); PG8_BAR; PG8_WAIT_L(0); PG8_MMA(0, 0, At, B0); PG8_BAR; PG8_SCHED;
            PG8_LDB(B1, 0, 1); PG8_STB(PG8_SB(0, 0), b2);
            PG8_BAR; PG8_WAIT_L(0); PG8_MMA(0, 1, At, B1); PG8_BAR;
            PG8_LDA(At, 0, 1); PG8_STA(PG8_SA(0, 0), a2, 0, s00, s01);
            PG8_BAR; PG8_WAIT_L(0); PG8_MMA(1, 0, At, B0); PG8_BAR; PG8_SCHED;
            PG8_STB(PG8_SB(0, 1), b2 + hstepB);
            PG8_WAIT_V(6); PG8_BAR; PG8_MMA(1, 1, At, B1); PG8_BAR;
            PG8_LDB(B0, 1, 0); PG8_SCHED; PG8_LDA(At, 1, 0); PG8_STA(PG8_SA(0, 1), a2, 1, s10, s11);
            PG8_WAIT_L(8); PG8_BAR; PG8_WAIT_L(0); PG8_MMA(0, 0, At, B0); PG8_BAR; PG8_SCHED;
            PG8_LDB(B1, 1, 1); PG8_STB(PG8_SB(1, 0), b3);
            PG8_BAR; PG8_WAIT_L(0); PG8_MMA(0, 1, At, B1); PG8_BAR;
            PG8_LDA(At, 1, 1); PG8_STA(PG8_SA(1, 0), a3, 0, s00, s01);
            PG8_BAR; PG8_WAIT_L(0); PG8_MMA(1, 0, At, B0); PG8_BAR; PG8_SCHED;
            PG8_STB(PG8_SB(1, 1), b3 + hstepB);
            PG8_WAIT_V(6); PG8_BAR; PG8_MMA(1, 1, At, B1); PG8_BAR;
            }
            if constexpr (CATK) { if (t == 0) { int fr2 = fr, fq2 = fq; asm volatile("" : "+v"(fr2), "+v"(fq2)); E.mid(acc, cur, wr, wc, fr2, fq2); } }
        }
        if constexpr (ALIGN_EPI) { if (wr == 0) PG8_BAR; }
        if constexpr (FP8) {
#define PG8_T8(a, b) "+v"(acc[a][b][0][0]), "+v"(acc[a][b][0][1]), "+v"(acc[a][b][1][0]), "+v"(acc[a][b][1][1]), "+v"(acc[a][b][2][0]), "+v"(acc[a][b][2][1]), "+v"(acc[a][b][3][0]), "+v"(acc[a][b][3][1])
            asm volatile("s_nop 15\n\ts_nop 7" : PG8_T8(0, 0), PG8_T8(0, 1));
            asm volatile("" : PG8_T8(1, 0), PG8_T8(1, 1));
#undef PG8_T8
        }
        if constexpr (EPF) E(acc, cur, wr, wc, fr, fq, lds + LDS_EPI_OFF + (ui % 3) * LDS_EPI_BUF); else E(acc, cur, wr, wc, fr, fq);
        if (!has_next) break;
#pragma unroll
        for (int a = 0; a < 2; ++a)
#pragma unroll
            for (int b = 0; b < 2; ++b)
#pragma unroll
                for (int m = 0; m < 4; ++m)
#pragma unroll
                    for (int n = 0; n < 2; ++n) acc[a][b][m][n] = (f32x4){0.f, 0.f, 0.f, 0.f};
        cur = nxt; cA = nA; cB = nB; co = no; ++ui; ca00 = na00; ca01 = na01; ca10 = na10; ca11 = na11;
        if constexpr (ALIGN_EPI) { if (wr == 1) PG8_BAR; }
    }
    PG8_WAIT_V(0);
    if constexpr (!ALIGN_EPI) { if (wr == 0) PG8_BAR; }
    PG8_BAR;
#undef PG8_SA
#undef PG8_SB
#undef PG8_ST2
#undef PG8_STB
#undef PG8_STA
#undef PG8_LDA
#undef PG8_LDB
#undef PG8_MMA
#undef PG8_WAIT_V
#undef PG8_WAIT_L
#undef PG8_BAR
#undef PG8_SCHED
}
}
using pg8::Unit;
typedef f32x4 Acc[2][2][4][2];

__device__ __forceinline__ void glds4(const float* src_lane, LAS unsigned char* dst_wave) { __builtin_amdgcn_global_load_lds((const unsigned*)src_lane, (LAS unsigned*)dst_wave, 4, 0, 0); }
template <bool GATES>
struct EpiIn {
    const float* rinv; const float* b_in; bf16_t* U; bf16_t* A; bf16_t* GA; bf16_t* GB;
    __device__ __forceinline__ void prefetch(LAS unsigned char* ebuf, const Unit& u, int wid, int lane) const {
        if (wid < 4) glds4(rinv + (size_t)u.pm * 256 + wid * 64 + lane, ebuf + wid * 256);
        else { const int c = (wid - 4) * 64 + lane, pn = GATES ? u.pn + 6 : u.pn; int col = 256 * pn + c;
            if (pn >= 2 && pn < 6) col = (wid < 6) ? 512 + 128 * (pn - 2) + c : 1024 + 128 * (pn - 2) + (c - 128);
            glds4(b_in + col, ebuf + 1024 + (wid - 4) * 256); }
    }
    __device__ __forceinline__ void operator()(const Acc& acc, const Unit& u, int wr, int wc, int fr, int fq, const LAS unsigned char* ebuf) const {
        const int cc = wc * 32 + 8 * fq, pn = GATES ? u.pn + 6 : u.pn;
        const LAS float* rl_ = (const LAS float*)ebuf; const LAS float* bl = (const LAS float*)(ebuf + 1024);
        f32x4 bv[2][2];
#pragma unroll
        for (int bj = 0; bj < 2; ++bj)
#pragma unroll
            for (int n = 0; n < 2; ++n) bv[bj][n] = *(const LAS f32x4*)(bl + 128 * bj + cc + 4 * n);
#pragma unroll
        for (int ai = 0; ai < 2; ++ai)
#pragma unroll
            for (int m = 0; m < 4; ++m) {
                const int rl = ai * 128 + wr * 64 + m * 16 + fr, r = u.pm * 256 + rl; const float ri = rl_[rl];
                if (!GATES && pn < 2) {
#pragma unroll
                    for (int bj = 0; bj < 2; ++bj) { const f32x4 v0 = acc[ai][bj][m][0] * ri + bv[bj][0], v1 = acc[ai][bj][m][1] * ri + bv[bj][1];
                        *(u32x4*)(U + (size_t)r * PW + 256 * pn + 128 * bj + cc) = pack8(v0, v1); }
                } else if (!GATES) {
                    f32x4 o[2]; const float rin = ri * -1.44269504f;
#pragma unroll
                    for (int n = 0; n < 2; ++n)
#pragma unroll
                        for (int j = 0; j < 4; ++j) o[n][j] = __builtin_fmaf(acc[ai][0][m][n][j], ri, bv[0][n][j]) * __builtin_amdgcn_rcpf(1.0f + __builtin_amdgcn_exp2f(__builtin_fmaf(acc[ai][1][m][n][j], rin, bv[1][n][j] * -1.44269504f)));
                    *(u32x4*)(A + (size_t)r * CW + 128 * (pn - 2) + cc) = pack8(o[0], o[1]);
                } else {
                    bf16_t* O = (pn < 10) ? GA : GB; const int c0 = 256 * ((pn < 10) ? pn - 6 : pn - 10); const float rin = ri * (-1.44269504f / (F8_SA * F8_SW));
#pragma unroll
                    for (int bj = 0; bj < 2; ++bj) { f32x4 o[2];
#pragma unroll
                        for (int n = 0; n < 2; ++n)
#pragma unroll
                            for (int j = 0; j < 4; ++j) o[n][j] = __builtin_amdgcn_rcpf(1.0f + __builtin_amdgcn_exp2f(__builtin_fmaf(acc[ai][bj][m][n][j], rin, bv[bj][n][j] * -1.44269504f)));
                        u32x2 w; w.x = pack4_u8(o[0]); w.y = pack4_u8(o[1]); *(u32x2*)((unsigned char*)O + (size_t)r * D + c0 + 128 * bj + cc) = w; }
                }
            }
    }
};
struct EpiMix {
    const unsigned char* GA; const unsigned char* GB; const float* bias; bf16_t* MIXED;
    __device__ __forceinline__ void mid(Acc& acc, const Unit& u, int wr, int wc, int fr, int fq) const {
        const int row0 = u.pm * 256 + wr * 64 + fr, col0 = u.pn * 256 + wc * 32 + 8 * fq;
#pragma unroll
        for (int ai = 0; ai < 2; ++ai)
#pragma unroll
            for (int m = 0; m < 4; ++m) { const size_t off = (size_t)(row0 + ai * 128 + m * 16) * D + col0;
#pragma unroll
                for (int bj = 0; bj < 2; ++bj) { const u32x2 ga = *(const u32x2*)(GA + off + bj * 128), gb = *(const u32x2*)(GB + off + bj * 128);
                    const f32x4 a0 = unpack4_u8(ga.x), a1 = unpack4_u8(ga.y), b0 = unpack4_u8(gb.x), b1 = unpack4_u8(gb.y);
#pragma unroll
                    for (int j = 0; j < 4; ++j) { acc[ai][bj][m][0][j] *= a0[j] * __builtin_amdgcn_rcpf(fmaxf(b0[j], 1.0f / 255.0f)); acc[ai][bj][m][1][j] *= a1[j] * __builtin_amdgcn_rcpf(fmaxf(b1[j], 1.0f / 255.0f)); }
                    asm volatile("" ::: "memory"); } }
    }
    __device__ __forceinline__ void operator()(const Acc& acc, const Unit& u, int wr, int wc, int fr, int fq) const {
        const int row0 = u.pm * 256 + wr * 64 + fr, col0 = u.pn * 256 + wc * 32 + 8 * fq;
#pragma unroll
        for (int bj = 0; bj < 2; ++bj) {
            const f32x4 b0 = *(const f32x4*)(bias + col0 + bj * 128), b1 = *(const f32x4*)(bias + col0 + bj * 128 + 4);
#pragma unroll
            for (int ai = 0; ai < 2; ++ai)
#pragma unroll
                for (int m = 0; m < 4; ++m) { const size_t off = (size_t)(row0 + ai * 128 + m * 16) * D + col0 + bj * 128;
                    const u32x2 gw = *(const u32x2*)(GB + off); f32x4 g0 = unpack4_u8(gw.x), g1 = unpack4_u8(gw.y);
#pragma unroll
                    for (int j = 0; j < 4; ++j) { g0[j] = fmaxf(g0[j], 1.0f / 255.0f); g1[j] = fmaxf(g1[j], 1.0f / 255.0f); }
                    *(u32x4*)(MIXED + off) = pack8(g0 * (acc[ai][bj][m][0] + b0), g1 * (acc[ai][bj][m][1] + b1));
                    asm volatile("" ::: "memory"); }
        }
    }
};
struct EpiOut {
    const bf16_t* x; bf16_t* H1; bf16_t* H1B;
    __device__ __forceinline__ void operator()(const Acc& acc, const Unit& u, int wr, int wc, int fr, int fq) const {
        const int row0 = u.pm * 256 + wr * 64 + fr, col0 = u.pn * 256 + wc * 32 + 8 * fq;
#pragma unroll
        for (int ai = 0; ai < 2; ++ai)
#pragma unroll
            for (int m = 0; m < 4; ++m) { const size_t off = (size_t)(row0 + ai * 128 + m * 16) * D + col0;
#pragma unroll
                for (int bj = 0; bj < 2; ++bj) { f32x4 x0, x1; unpack8(*(const u32x4*)(x + off + bj * 128), x0, x1); const f32x4 h0 = x0 + acc[ai][bj][m][0], h1 = x1 + acc[ai][bj][m][1];
                    *(u32x4*)(H1 + off + bj * 128) = pack8(h0, h1);
                    if (MK_FP8) *(u32x2*)((unsigned char*)H1B + off + bj * 128) = pack8_fp8(h0, h1, F8_SA); } }
    }
};
struct EpiUp {
    const LAS int* tile_e; const float* rs; const float* bgu; bf16_t* ACT;
    __device__ __forceinline__ void prefetch(LAS unsigned char* ebuf, const Unit& u, int wid, int lane) const {
        const int e = u.pe;
        if (wid < 4) glds4(rs + (size_t)u.pm * 256 + wid * 64 + lane, ebuf + wid * 256);
        else { const int c = (wid - 4) * 64 + lane; glds4(bgu + (size_t)e * 2048 + (wid < 6 ? 128 * u.pn + c : 1024 + 128 * u.pn + (c - 128)), ebuf + 1024 + (wid - 4) * 256); }
    }
    __device__ __forceinline__ void operator()(const Acc& acc, const Unit& u, int wr, int wc, int fr, int fq, const LAS unsigned char* ebuf) const {
        const int row0 = u.pm * 256 + wr * 64 + fr, cc = wc * 32 + 8 * fq, j0 = 128 * u.pn + cc;
        const LAS float* rsl = (const LAS float*)ebuf; const LAS float* bl = (const LAS float*)(ebuf + 1024);
        f32x4 bg[2], bu[2];
#pragma unroll
        for (int n = 0; n < 2; ++n) { bg[n] = *(const LAS f32x4*)(bl + cc + 4 * n); bu[n] = *(const LAS f32x4*)(bl + 128 + cc + 4 * n); }
#pragma unroll
        for (int ai = 0; ai < 2; ++ai)
#pragma unroll
            for (int m = 0; m < 4; ++m) { if (u.ph == 2 - ai) continue;
                const int rl = ai * 128 + wr * 64 + m * 16 + fr, r = u.pm * 256 + rl; const float sc = rsl[rl]; f32x4 o[2];
#pragma unroll
                for (int n = 0; n < 2; ++n) {
#pragma unroll
                    for (int j = 0; j < 4; ++j) { const float gg = fminf(__builtin_fmaf(acc[ai][0][m][n][j], sc, bg[n][j]), SW_LIMIT), uu = fminf(fmaxf(__builtin_fmaf(acc[ai][1][m][n][j], sc, bu[n][j]), -SW_LIMIT), SW_LIMIT);
                        const float sg = gg * __builtin_amdgcn_rcpf(1.0f + __builtin_amdgcn_exp2f(gg * (-SW_ALPHA * 1.44269504f)));
                        o[n][j] = (MK_FP8 ? __builtin_fmaf(uu, F8_SACT, F8_SACT) : (uu + 1.0f)) * sg; } }
                if (MK_FP8) *(u32x2*)((unsigned char*)ACT + (size_t)r * DE + j0) = pack8_fp8_nc(o[0], o[1], 1.0f);     else *(u32x4*)(ACT + (size_t)r * DE + j0) = pack8(o[0], o[1]); }
        (void)row0;
    }
};
struct EpiDown {
    const LAS int* tile_e; const float* gate; const float* bdn; bf16_t* YC;
    __device__ __forceinline__ void prefetch(LAS unsigned char* ebuf, const Unit& u, int wid, int lane) const {
        const int e = u.pe;
        if (wid < 4) glds4(gate + (size_t)u.pm * 256 + wid * 64 + lane, ebuf + wid * 256);
        else glds4(bdn + (size_t)e * D + 256 * u.pn + (wid - 4) * 64 + lane, ebuf + 1024 + (wid - 4) * 256);
    }
    __device__ __forceinline__ void operator()(const Acc& acc, const Unit& u, int wr, int wc, int fr, int fq, const LAS unsigned char* ebuf) const {
        const int cl = wc * 32 + 8 * fq, col0 = u.pn * 256 + cl;
        const LAS float* gl = (const LAS float*)ebuf; const LAS float* bl = (const LAS float*)(ebuf + 1024);
        f32x4 bv[2][2];
#pragma unroll
        for (int bj = 0; bj < 2; ++bj)
#pragma unroll
            for (int n = 0; n < 2; ++n) bv[bj][n] = *(const LAS f32x4*)(bl + cl + bj * 128 + 4 * n);
        if (MK_FP8) {
            const int colw = u.pn * 256 + wc * 32 + 16 * (fq >> 1);
#pragma unroll
            for (int ai = 0; ai < 2; ++ai)
#pragma unroll
                for (int mp = 0; mp < 2; ++mp) { if (u.ph == 2 - ai) continue;
                    const int rla = ai * 128 + wr * 64 + (2 * mp) * 16 + fr, rlb = rla + 16; const float ga = gl[rla] * F8_SY, gb = gl[rlb] * F8_SY; const float dsc = 1.0f / (F8_SACT * F8_SW);
                    const int rl = (fq & 1) ? rlb : rla;
#pragma unroll
                    for (int bj = 0; bj < 2; ++bj) {
                        const u32x2 pa = pack8_fp8((acc[ai][bj][2 * mp][0] * dsc + bv[bj][0]) * ga, (acc[ai][bj][2 * mp][1] * dsc + bv[bj][1]) * ga, 1.0f);
                        const u32x2 pb = pack8_fp8((acc[ai][bj][2 * mp + 1][0] * dsc + bv[bj][0]) * gb, (acc[ai][bj][2 * mp + 1][1] * dsc + bv[bj][1]) * gb, 1.0f);
                        *(u32x4*)((unsigned char*)YC + (size_t)(u.pm * 256 + rl) * D + colw + bj * 128) = widen_pair(pa, pb, fq); } }
        } else {
#pragma unroll
        for (int ai = 0; ai < 2; ++ai)
#pragma unroll
            for (int m = 0; m < 4; ++m) { const int rl = ai * 128 + wr * 64 + m * 16 + fr, r = u.pm * 256 + rl; const float g = gl[rl];
#pragma unroll
                for (int bj = 0; bj < 2; ++bj) { const f32x4 y0 = (acc[ai][bj][m][0] + bv[bj][0]) * g, y1 = (acc[ai][bj][m][1] + bv[bj][1]) * g;
                    *(u32x4*)(YC + (size_t)r * D + col0 + bj * 128) = pack8(y0, y1); } }
        }
    }
};

#define XB_TMO      128
#define XB_XCNT(j)  (256  + 64 * (j))
#define XB_XSUB(j)  (1280 + 64 * (j))
#define XB_XGEN(j)  (2304 + 64 * (j))
#define XB_TOP      3328
#define XB_TOPGEN   3392
#define XCD_BAR_WORDS 3456
#define XB_SPIN_CAP (1u << 18)
__device__ __forceinline__ unsigned xb_ld(unsigned* p)              { return __hip_atomic_load(p, __ATOMIC_RELAXED, __HIP_MEMORY_SCOPE_AGENT); }
__device__ __forceinline__ unsigned xb_add(unsigned* p, unsigned v) { return __hip_atomic_fetch_add(p, v, __ATOMIC_RELAXED, __HIP_MEMORY_SCOPE_AGENT); }
__device__ __forceinline__ unsigned xb_xcc_id() { return (unsigned)__builtin_amdgcn_s_getreg((3 << 11) | 20) & 0xFu; }
#define XB_SPIN(cond, bar) do { unsigned _sp = 0; while (cond) { __builtin_amdgcn_s_sleep(1); \
    if ((++_sp & 255u) == 0u) { if (xb_ld(&(bar)[XB_TMO])) break; if (_sp > XB_SPIN_CAP) { atomicAdd(&(bar)[XB_TMO], 1u); break; } } } } while (0)
struct XcdBarrier { unsigned* bar; unsigned x; volatile LAS unsigned* st; };
__device__ __forceinline__ XcdBarrier xcd_barrier_post(unsigned* bar, volatile LAS unsigned* st) {
    XcdBarrier b; b.bar = bar; b.x = xb_xcc_id(); b.st = st;
    if (threadIdx.x == 0) (void)xb_add(&bar[XB_XCNT(b.x)], 1u);
    return b;
}
__device__ __forceinline__ void xcd_barrier_complete(unsigned* bar, unsigned x, unsigned& nloc, unsigned& nx) {
    const unsigned G = gridDim.x * gridDim.y * gridDim.z;
    unsigned sum, cnt, mine, sp = 0u;
    for (;;) {
        sum = 0u; cnt = 0u; mine = 0u;
#pragma unroll
        for (unsigned j = 0; j < 16; ++j) { const unsigned c = xb_ld(&bar[XB_XCNT(j)]); sum += c; cnt += (c > 0u) ? 1u : 0u; mine = (j == x) ? c : mine; }
        if (sum == G) break;
        __builtin_amdgcn_s_sleep(1);
        if ((++sp & 255u) == 0u) { if (xb_ld(&bar[XB_TMO])) break; if (sp > XB_SPIN_CAP) { atomicAdd(&bar[XB_TMO], 1u); break; } }
    }
    nloc = mine > 0u ? mine : 1u; nx = cnt > 0u ? cnt : 1u;
}
__device__ __forceinline__ void xcd_barrier(const XcdBarrier& b) {
    asm volatile("s_waitcnt vmcnt(0)" ::: "memory");
    __syncthreads();
    if (threadIdx.x == 0) {
        unsigned* bar = b.bar;
        __builtin_amdgcn_s_waitcnt(0);
        unsigned nloc = b.st[0], nx = b.st[1];
        if (nloc == 0u) { xcd_barrier_complete(bar, b.x, nloc, nx); b.st[0] = nloc; b.st[1] = nx; }
        const unsigned old = xb_add(&bar[XB_XSUB(b.x)], 1u);
        const unsigned gen = old / nloc;
        if (old + 1u == (gen + 1u) * nloc) {
            __builtin_amdgcn_fence(__ATOMIC_RELEASE, "agent");
            asm volatile("s_waitcnt vmcnt(0)" ::: "memory");
            const unsigned og = xb_add(&bar[XB_TOP], 1u);
            const unsigned tg = og / nx;
            if (og + 1u == (tg + 1u) * nx) xb_add(&bar[XB_TOPGEN], 1u);
            else XB_SPIN(xb_ld(&bar[XB_TOPGEN]) == tg, bar);
            __builtin_amdgcn_fence(__ATOMIC_ACQUIRE, "agent");
            xb_add(&bar[XB_XGEN(b.x)], 1u);
            asm volatile("s_waitcnt vmcnt(0)" ::: "memory");
        } else {
            XB_SPIN(xb_ld(&bar[XB_XGEN(b.x)]) == gen, bar);
            __builtin_amdgcn_fence(__ATOMIC_ACQUIRE, "agent");
            asm volatile("s_waitcnt vmcnt(0)" ::: "memory");
        }
    }
    __syncthreads();
}

__device__ __forceinline__ void xcd_arrive2(unsigned* barA, unsigned* barB, const XcdBarrier& b) {
    asm volatile("s_waitcnt vmcnt(0)" ::: "memory");
    __syncthreads();
    if (threadIdx.x == 0) {
        __builtin_amdgcn_s_waitcnt(0);
        unsigned nloc = b.st[0], nx = b.st[1];
        if (nloc == 0u) { xcd_barrier_complete(barA, b.x, nloc, nx); b.st[0] = nloc; b.st[1] = nx; }
        const unsigned old = xb_add(&barB[XB_XSUB(b.x)], 1u);
        const unsigned gen = old / nloc;
        if (old + 1u == (gen + 1u) * nloc) {
            __builtin_amdgcn_fence(__ATOMIC_RELEASE, "agent");
            asm volatile("s_waitcnt vmcnt(0)" ::: "memory");
            const unsigned og = xb_add(&barB[XB_TOP], 1u);
            const unsigned tg = og / nx;
            if (og + 1u == (tg + 1u) * nx) xb_add(&barB[XB_TOPGEN], 1u);
        }
    }
}
__device__ __forceinline__ void xcd_wait2(unsigned* barA, unsigned* barB, unsigned k) {
    asm volatile("s_waitcnt vmcnt(0)" ::: "memory");
    __syncthreads();
    if (threadIdx.x == 0) {
        XB_SPIN(xb_ld(&barB[XB_TOPGEN]) <= k, barA);
        __builtin_amdgcn_fence(__ATOMIC_ACQUIRE, "agent");
        asm volatile("s_waitcnt vmcnt(0)" ::: "memory");
    }
    __syncthreads();
}

struct Args {
    const float* in[22]; float* out; unsigned char* ws; int ph_lo, ph_hi, bar_region, pad;
};
struct Frame {
    LAS unsigned char* lds; int tid, lane, wave, vcu, G;
    const float *x, *meta, *g1, *w_in, *b_in, *w_pool, *pool_scale, *w_dw, *b_dw, *ln_g, *ln_b, *w_pw2, *b_pw2, *w_out, *g2, *router_w, *router_b, *w_gu, *b_gu, *w_dn, *b_dn, *gf;
    float* out; unsigned char* ws;
};

__device__ __forceinline__ int rowmap(int mode, int n) {
    if (mode == 1) { if (n >= 512 && n < 1024) { const int c = n - 512; return 512 + (c >> 7) * 256 + (c & 127); } if (n >= 1024 && n < 1536) { const int c = n - 1024; return 512 + (c >> 7) * 256 + 128 + (c & 127); } return n; }
    if (mode == 2) { if (n < 1024) return (n >> 7) * 256 + (n & 127); const int c = n - 1024; return (c >> 7) * 256 + 128 + (c & 127); }
    return n;
}
__device__ __forceinline__ void p0_transpose_item(const float* W, int K, int N, const float* sk, const float* sn, bf16_t* WT, int mode, LAS float* scr, int item, int lane, int ldo = 0, int ldw = 0) {
    if (ldo == 0) ldo = K;
    if (ldw == 0) ldw = N;
    const int nblk = N / 64, kb = item / nblk, nb = item % nblk, k0 = 64 * kb, n0 = 64 * nb;
    const int r4 = lane >> 4, c16 = lane & 15;
    f32x4 v[16];
#pragma unroll
    for (int i = 0; i < 16; ++i) v[i] = __builtin_nontemporal_load((const f32x4*)(W + (size_t)(k0 + 4 * i + r4) * ldw + n0 + 4 * c16));
    f32x4 snv = (f32x4){1.f, 1.f, 1.f, 1.f}; if (sn) snv = *(const f32x4*)(sn + n0 + 4 * c16);
#pragma unroll
    for (int i = 0; i < 16; ++i) { const int kk = 4 * i + r4; const float skv = sk ? sk[k0 + kk] : 1.0f; const f32x4 o = v[i] * snv * skv; LAS float* d = scr + kk * 65 + 4 * c16; d[0] = o[0]; d[1] = o[1]; d[2] = o[2]; d[3] = o[3]; }
    LDS_WAIT(); asm volatile("" ::: "memory");
    const int c = lane & 7;
#pragma unroll
    for (int j = 0; j < 8; ++j) { const int n = (lane >> 3) + 8 * j; const LAS float* s = scr + (8 * c) * 65 + n;
        u32x4 o; o.x = cvt_pk_bf16(s[0 * 65], s[1 * 65]); o.y = cvt_pk_bf16(s[2 * 65], s[3 * 65]); o.z = cvt_pk_bf16(s[4 * 65], s[5 * 65]); o.w = cvt_pk_bf16(s[6 * 65], s[7 * 65]);
        *(u32x4*)(WT + (size_t)rowmap(mode, n0 + n) * ldo + k0 + 8 * c) = o; }
    LDS_WAIT(); asm volatile("" ::: "memory");
}

struct T8Item { const float* W; const float* sk; unsigned char* WT; int K, N, mode, item, ldw; };
__device__ __forceinline__ void t8_load(const T8Item& t, f32x4 (&v)[16], int lane) {
    const int nblk = t.N / 32, kb = t.item / nblk, nb = t.item % nblk, k0 = 128 * kb, n0 = 32 * nb, r8 = lane >> 3, c8 = lane & 7;
#pragma unroll
    for (int i = 0; i < 16; ++i) v[i] = __builtin_nontemporal_load((const f32x4*)(t.W + (size_t)(k0 + 8 * i + r8) * t.ldw + n0 + 4 * c8));
}
__device__ __forceinline__ void t8_finish(const T8Item& t, const f32x4 (&v)[16], float scale, LAS float* scr, int lane) {
    const int nblk = t.N / 32, kb = t.item / nblk, nb = t.item % nblk, k0 = 128 * kb, n0 = 32 * nb, r8 = lane >> 3, c8 = lane & 7;
#pragma unroll
    for (int i = 0; i < 16; ++i) { const int kk = 8 * i + r8; const float skv = (t.sk ? t.sk[k0 + kk] : 1.0f) * scale; const f32x4 o = v[i] * skv; LAS float* d = scr + kk * 33 + 4 * (kk >> 4) + 4 * c8; d[0] = o[0]; d[1] = o[1]; d[2] = o[2]; d[3] = o[3]; }
    LDS_WAIT(); asm volatile("" ::: "memory");
    const int c = lane & 7;
#pragma unroll
    for (int j = 0; j < 4; ++j) { const int n = (lane >> 3) + 8 * j; const LAS float* s = scr + (16 * c) * 33 + 4 * c + n;
        u32x4 o; o.x = pack4_fp8(s[0 * 33], s[1 * 33], s[2 * 33], s[3 * 33]); o.y = pack4_fp8(s[4 * 33], s[5 * 33], s[6 * 33], s[7 * 33]);
        o.z = pack4_fp8(s[8 * 33], s[9 * 33], s[10 * 33], s[11 * 33]); o.w = pack4_fp8(s[12 * 33], s[13 * 33], s[14 * 33], s[15 * 33]);
        *(u32x4*)(t.WT + (size_t)rowmap(t.mode, n0 + n) * t.K + k0 + 16 * c) = o; }
    LDS_WAIT(); asm volatile("" ::: "memory");
}
__device__ __forceinline__ void p0_transpose_item8(const float* W, int K, int N, const float* sk, float scale, unsigned char* WT, int mode, LAS float* scr, int item, int lane, int ldw = 0) {
    const T8Item t{W, sk, WT, K, N, mode, item, ldw ? ldw : N}; f32x4 v[16]; t8_load(t, v, lane); t8_finish(t, v, scale, scr, lane);
}

constexpr int META_KS = 32;
__device__ __forceinline__ void p0_prologue(Frame& F) {
    LAS float* scr = (LAS float*)(F.lds + F.wave * 17408);
    const int gw = F.vcu * NWAVES + F.wave, NGW = F.G * NWAVES, lane = F.lane;
    unsigned char* ws = F.ws;
    bf16_t* W1T = (bf16_t*)(ws + WS_W1T); bf16_t* WPT = (bf16_t*)(ws + WS_WPT); bf16_t* PW2T = (bf16_t*)(ws + WS_PW2T); bf16_t* OUTT = (bf16_t*)(ws + WS_OUTT);
    bf16_t* GUT = (bf16_t*)(ws + WS_GUT); bf16_t* DNT = (bf16_t*)(ws + WS_DNT);
    constexpr int I_W1 = (D / 64) * (1536 / 64), I_W1G = (D / 128) * (2048 / 32), I_P = 4 * (128 / 64) * (256 / 64), I_PW2 = (CW / 64) * (D / 64), I_OUT = (D / 64) * (D / 64);
    constexpr int I_GU1 = MK_FP8 ? (D / 128) * (2 * DE / 32) : (D / 64) * (2 * DE / 64), I_DN1 = MK_FP8 ? (DE / 128) * (D / 32) : (DE / 64) * (D / 64), I_GU = NE * I_GU1, I_DN = NE * I_DN1;
    constexpr int I_WR = 16, I_META = 24 * META_KS + 1;
    constexpr int NITEMS_A = I_WR + I_META + I_W1 + I_W1G + I_P + I_PW2 + I_OUT, NITEMS = NITEMS_A + I_GU + I_DN;
    for (int it = gw; it < NITEMS_A; it += NGW) {
        int r = it;
        if (r < I_WR) {
            bf16_t* wrt = (bf16_t*)(ws + WS_MISC + M_WRT); const int k = 64 * r + lane; const float g = F.g2[k];
            for (int e = 0; e < NE; ++e) { const float v = F.router_w[(size_t)k * NE + e] * g; const unsigned hi = cvt_pk_bf16(v, 0.f) & 0xffffu; const float rem = v - __uint_as_float(hi << 16);
                wrt[(size_t)e * D + k] = (bf16_t)hi; wrt[(size_t)(NE + e) * D + k] = (bf16_t)(cvt_pk_bf16(rem, 0.f) & 0xffffu); }
            continue;
        }
        r -= I_WR;
        if (r < I_META) {
            if (r == 24 * META_KS) {
                for (int i = 0; i < NMETA; ++i) { float s = 0.f;
#pragma unroll
                    for (int j = 0; j < 4; ++j) { const f32x4 v = *(const f32x4*)(F.meta + (size_t)i * D + 4 * lane + 256 * j); s += (v[0] * v[0] + v[1] * v[1]) + (v[2] * v[2] + v[3] * v[3]); }
                    s = wave_sum(s); if (lane == 0) ((float*)(ws + WS_MISC + M_METAR))[i] = 1.0f / sqrtf(s * (1.0f / D) + RMS_EPS); }
            } else {
                const int cc = r / META_KS, ks = r % META_KS, n = cc * 64 + lane, kb = ks * (D / META_KS); float a[NMETA]; float wv[D / META_KS];
#pragma unroll
                for (int k = 0; k < D / META_KS; ++k) wv[k] = F.w_in[(size_t)(kb + k) * NCOL1 + n];
#pragma unroll
                for (int i = 0; i < NMETA; ++i) a[i] = 0.f;
#pragma unroll
                for (int k = 0; k < D / META_KS; ++k) { const float w = wv[k] * F.g1[kb + k];
#pragma unroll
                    for (int i = 0; i < NMETA; ++i) a[i] += F.meta[(size_t)i * D + kb + k] * w; }
                float* mp = (float*)(ws + WS_METAP);
#pragma unroll
                for (int i = 0; i < NMETA; ++i) mp[((size_t)ks * NMETA + i) * 1536 + n] = a[i];
            }
            continue;
        }
        r -= I_META;
        if (r < I_W1) { p0_transpose_item(F.w_in, D, 1536, F.g1, nullptr, W1T, 1, scr, r, lane, 0, NCOL1); continue; } r -= I_W1;
        if (r < I_W1G) { p0_transpose_item8(F.w_in + 1536, D, 2048, F.g1, F8_SW, ws + WS_W1G8, 0, scr, r, lane, NCOL1); continue; } r -= I_W1G;
        if (r < I_P) { const int g = r / 8; p0_transpose_item(F.w_pool + (size_t)g * 128 * 256, 128, 256, nullptr, F.pool_scale + g * 256, WPT + (size_t)g * 256 * 640, 0, scr, r % 8, lane, 640); continue; } r -= I_P;
        if (r < I_PW2) { p0_transpose_item(F.w_pw2, CW, D, nullptr, nullptr, WPT + 128, 0, scr, r, lane, 640); continue; } r -= I_PW2;
        if (r < I_OUT) { p0_transpose_item(F.w_out, D, D, nullptr, nullptr, OUTT, 0, scr, r, lane); continue; }
    }
    bf16_t* XB = (bf16_t*)(ws + WS_XB); float* rinv1 = (float*)(ws + WS_MISC + M_RINV1);
    for (int m = 4 * gw; m < NTOK; m += 4 * NGW) {
        f32x4 v[4][4];
#pragma unroll
        for (int q = 0; q < 4; ++q)
#pragma unroll
            for (int j = 0; j < 4; ++j) v[q][j] = __builtin_nontemporal_load((const f32x4*)(F.x + (size_t)(m + q) * D) + lane + 64 * j);
#pragma unroll
        for (int q = 0; q < 4; ++q) { float s = 0.f;
#pragma unroll
            for (int j = 0; j < 4; ++j) s += (v[q][j][0] * v[q][j][0] + v[q][j][1] * v[q][j][1]) + (v[q][j][2] * v[q][j][2] + v[q][j][3] * v[q][j][3]);
            s = wave_sum(s);
            u32x2* o8 = (u32x2*)(XB + (size_t)(m + q) * D) + lane; unsigned* q8 = (unsigned*)(ws + WS_XQ8 + (size_t)(m + q) * D) + lane;
#pragma unroll
            for (int j = 0; j < 4; ++j) { u32x2 w; w.x = cvt_pk_bf16(v[q][j][0], v[q][j][1]); w.y = cvt_pk_bf16(v[q][j][2], v[q][j][3]); o8[64 * j] = w;
                q8[64 * j] = pack4_fp8(v[q][j][0] * F8_SA, v[q][j][1] * F8_SA, v[q][j][2] * F8_SA, v[q][j][3] * F8_SA); }
            if (lane == 0) rinv1[m + q] = 1.0f / sqrtf(s * (1.0f / D) + RMS_EPS); }
    }
}

constexpr int P0B_NJ = 12;
__device__ __forceinline__ void p0b_expert_weights(LAS unsigned char* lds, int vcu, int G, int wave, int lane, int j0, int j1) {
    const char* kp = (const char*)__builtin_amdgcn_kernarg_segment_ptr(); asm volatile("" : "+s"(kp));
    const float* const* inp = (const float* const*)kp;
    const float* g2 = inp[14]; const float* w_gu = inp[17]; const float* w_dn = inp[19]; unsigned char* ws = *(unsigned char* const*)(kp + 23 * 8);
    LAS float* scr = (LAS float*)(lds + wave * 17408);
    const int gw = vcu * NWAVES + wave, NGW = G * NWAVES;
    bf16_t* GUT = (bf16_t*)(ws + WS_GUT); bf16_t* DNT = (bf16_t*)(ws + WS_DNT);
    constexpr int I_GU1 = MK_FP8 ? (D / 128) * (2 * DE / 32) : (D / 64) * (2 * DE / 64), I_DN1 = MK_FP8 ? (DE / 128) * (D / 32) : (DE / 64) * (D / 64), I_GU = NE * I_GU1, I_DN = NE * I_DN1;
    if (MK_FP8) {
        auto mk = [&](int r) { T8Item t; if (r < I_GU) { const int e = r / I_GU1; t = T8Item{w_gu + (size_t)e * D * 2 * DE, g2, (unsigned char*)GUT + (size_t)e * 2 * DE * D, D, 2 * DE, 2, r % I_GU1, 2 * DE}; }
                               else { const int q = r - I_GU, e = q / I_DN1; t = T8Item{w_dn + (size_t)e * DE * D, nullptr, (unsigned char*)DNT + (size_t)e * D * DE, DE, D, 0, q % I_DN1, D}; } return t; };
        constexpr int NI = I_GU + I_DN;
        const int rend = (NGW * P0B_NJ >= NI) ? gw + j1 * NGW : NI;
        f32x4 va[16], vb[16]; int r = gw + j0 * NGW; T8Item ta, tb;
        auto ok = [&](int q) { return q < NI && q < rend; };
        if (ok(r)) { ta = mk(r); t8_load(ta, va, lane); }
        while (ok(r)) {
            int r2 = r + NGW; if (ok(r2)) { tb = mk(r2); t8_load(tb, vb, lane); }
            t8_finish(ta, va, F8_SW, scr, lane);
            r = r2; if (!ok(r)) break;
            r2 = r + NGW; if (ok(r2)) { ta = mk(r2); t8_load(ta, va, lane); }
            t8_finish(tb, vb, F8_SW, scr, lane);
            r = r2;
        }
    } else {
        for (int r = gw; j0 == 0 && r < I_GU + I_DN; r += NGW) {
            if (r < I_GU) { const int e = r / I_GU1; p0_transpose_item(w_gu + (size_t)e * D * 2 * DE, D, 2 * DE, g2, nullptr, GUT + (size_t)e * 2 * DE * D, 2, scr, r % I_GU1, lane); }
            else { const int q = r - I_GU, e = q / I_DN1; p0_transpose_item(w_dn + (size_t)e * DE * D, DE, D, nullptr, nullptr, DNT + (size_t)e * D * DE, 0, scr, q % I_DN1, lane); }
        }
    }
}

__device__ __forceinline__ void p1_meta_finish(Frame& F) {
    const int per = (NMETA * 512 + F.G - 1) / F.G;
    const int o = F.vcu * per + F.tid; if (F.tid >= per || o >= NMETA * 512) return;
    const int i = o >> 9, c = o & 511; unsigned char* ws = F.ws;
    const float* mp = (const float*)(ws + WS_METAP); const float ri = ((const float*)(ws + WS_MISC + M_METAR))[i];
    float su = 0.f, sv = 0.f, sg = 0.f;
#pragma unroll
    for (int ks = 0; ks < META_KS; ++ks) { const float* p = mp + ((size_t)ks * NMETA + i) * 1536; su += p[c]; sv += p[512 + c]; sg += p[1024 + c]; }
    const float uu = su * ri + F.b_in[c], vv = sv * ri + F.b_in[512 + c], gg = sg * ri + F.b_in[1024 + c];
    ((bf16_t*)(ws + WS_MISC + M_UMETA))[o] = (bf16_t)(cvt_pk_bf16(uu, 0.f) & 0xffffu);
    ((bf16_t*)(ws + WS_MISC + M_AMETA))[o] = (bf16_t)(cvt_pk_bf16(vv * sigmoidf_(gg), 0.f) & 0xffffu);
}

__device__ __forceinline__ void p2_mixer_pre(Frame& F) {
    LAS bf16_t* wl = (LAS bf16_t*)(F.lds);
    LAS bf16_t* at = (LAS bf16_t*)(F.lds + 31744);
    LAS bf16_t* ut = (LAS bf16_t*)(F.lds + 31744 + 63488);
    unsigned char* ws = F.ws; const int tid = F.tid, lane = F.lane, w = F.wave;
    const bf16_t* Ag = (const bf16_t*)(ws + WS_A); const bf16_t* Ug = (const bf16_t*)(ws + WS_U);
    const bf16_t* am = (const bf16_t*)(ws + WS_MISC + M_AMETA); const bf16_t* um = (const bf16_t*)(ws + WS_MISC + M_UMETA);
    bf16_t* DP = (bf16_t*)(ws + WS_DP);
    __syncthreads();
    for (int idx = tid; idx < CK * 64; idx += NTHREADS) { const f32x4 a = *(const f32x4*)(F.w_dw + idx * 8), b = *(const f32x4*)(F.w_dw + idx * 8 + 4); *(LAS u32x4*)(wl + idx * 8) = pack8(a, b); }
    const int c0 = 8 * lane;
    f32x4 bdw[2], lg[2], lb[2];
#pragma unroll
    for (int n = 0; n < 2; ++n) { bdw[n] = *(const f32x4*)(F.b_dw + c0 + 4 * n); lg[n] = *(const f32x4*)(F.ln_g + c0 + 4 * n); lb[n] = *(const f32x4*)(F.ln_b + c0 + 4 * n); }
    const int win = 2 << (lane >> 4); const float winv = 1.0f / (float)win;
    constexpr int NT = NTOK / 32, NA = 62 * 64, NU = 47 * 64;
    u32x4 ra[8], ru[6];
#define P2_LOAD(tile_) do { const int b_ = (tile_) >> 7, t0_ = ((tile_) & 127) << 5; \
        _Pragma("unroll") for (int q = 0; q < 8; ++q) { const int idx = tid + q * NTHREADS; ra[q] = (u32x4){0u, 0u, 0u, 0u}; \
            if (idx < NA) { const int row = idx >> 6, ch = (idx & 63) * 8, tr = t0_ - 30 + row; \
                if (tr >= 0) ra[q] = *(const u32x4*)(Ag + ((size_t)b_ * SEQ + tr) * CW + ch); else if (tr >= -NMETA) ra[q] = *(const u32x4*)(am + (NMETA + tr) * CW + ch); } } \
        _Pragma("unroll") for (int q = 0; q < 6; ++q) { const int idx = tid + q * NTHREADS; ru[q] = (u32x4){0u, 0u, 0u, 0u}; \
            if (idx < NU) { const int row = idx >> 6, ch = (idx & 63) * 8, tr = t0_ - 15 + row; \
                if (tr >= 0) ru[q] = *(const u32x4*)(Ug + ((size_t)b_ * SEQ + tr) * PW + ch); else ru[q] = *(const u32x4*)(um + (NMETA + tr) * PW + ch); } } } while (0)
    int tile = F.vcu;
    if (tile < NT) P2_LOAD(tile);
    for (; tile < NT; tile += F.G) {
        const int b = tile >> 7, t0 = (tile & 127) << 5;
        __syncthreads();
#pragma unroll
        for (int q = 0; q < 8; ++q) { const int idx = tid + q * NTHREADS; if (idx < NA) *(LAS u32x4*)(at + idx * 8) = ra[q]; }
#pragma unroll
        for (int q = 0; q < 6; ++q) { const int idx = tid + q * NTHREADS; if (idx < NU) *(LAS u32x4*)(ut + idx * 8) = ru[q]; }
        __syncthreads();
        if (tile + F.G < NT) P2_LOAD(tile + F.G);
        const int tl0 = 4 * w;
        f32x4 acc[4][2];
#pragma unroll
        for (int i = 0; i < 4; ++i) { acc[i][0] = (f32x4){0.f, 0.f, 0.f, 0.f}; acc[i][1] = (f32x4){0.f, 0.f, 0.f, 0.f}; }
        f32x4 r0[2], r1[2], r2[2], r3[2];
        unpack8(*(const LAS u32x4*)(at + (tl0 + 0) * 512 + c0), r0[0], r0[1]); unpack8(*(const LAS u32x4*)(at + (tl0 + 1) * 512 + c0), r1[0], r1[1]); unpack8(*(const LAS u32x4*)(at + (tl0 + 2) * 512 + c0), r2[0], r2[1]);
#pragma unroll 4
        for (int j = 0; j < CK; ++j) {
            f32x4 wv[2]; unpack8(*(const LAS u32x4*)(at + (tl0 + j + 3) * 512 + c0), r3[0], r3[1]); unpack8(*(const LAS u32x4*)(wl + j * 512 + c0), wv[0], wv[1]);
#pragma unroll
            for (int n = 0; n < 2; ++n) { acc[0][n] += wv[n] * r0[n]; acc[1][n] += wv[n] * r1[n]; acc[2][n] += wv[n] * r2[n]; acc[3][n] += wv[n] * r3[n]; r0[n] = r1[n]; r1[n] = r2[n]; r2[n] = r3[n]; }
        }
        f32x4 s0 = (f32x4){0.f, 0.f, 0.f, 0.f}, s1 = s0;
        for (int k = 0; k < win; ++k) { f32x4 x0, x1; unpack8(*(const LAS u32x4*)(ut + (tl0 + 15 - k) * 512 + c0), x0, x1); s0 += x0; s1 += x1; }
#pragma unroll
        for (int i = 0; i < 4; ++i) {
            const int tl = tl0 + i; const size_t orow = (size_t)b * SEQ + t0 + tl;
            f32x4 c[2]; c[0] = acc[i][0] + bdw[0]; c[1] = acc[i][1] + bdw[1];
            float s = (c[0][0] + c[0][1]) + (c[0][2] + c[0][3]) + (c[1][0] + c[1][1]) + (c[1][2] + c[1][3]);
            const float mean = wave_sum(s) * (1.0f / CW);
            c[0] = c[0] - mean; c[1] = c[1] - mean;
            float q = (c[0][0] * c[0][0] + c[0][1] * c[0][1]) + (c[0][2] * c[0][2] + c[0][3] * c[0][3]) + (c[1][0] * c[1][0] + c[1][1] * c[1][1]) + (c[1][2] * c[1][2] + c[1][3] * c[1][3]);
            const float rstd = 1.0f / sqrtf(wave_sum(q) * (1.0f / CW) + LN_EPS);
            f32x4 o[2];
#pragma unroll
            for (int n = 0; n < 2; ++n)
#pragma unroll
                for (int j = 0; j < 4; ++j) { const float cn = c[n][j] * rstd * lg[n][j] + lb[n][j]; o[n][j] = cn * sigmoidf_(cn); }
            *(u32x4*)(DP + orow * D + 512 + c0) = pack8(o[0], o[1]);
            f32x4 u0, u1; unpack8(*(const LAS u32x4*)(ut + (tl + 15) * 512 + c0), u0, u1);
            if (i > 0) { f32x4 x0, x1; unpack8(*(const LAS u32x4*)(ut + (tl + 15 - win) * 512 + c0), x0, x1); s0 += u0 - x0; s1 += u1 - x1; }
            *(u32x4*)(DP + orow * D + c0) = pack8(s0 * winv - u0, s1 * winv - u1);
        }
    }
#undef P2_LOAD
    __syncthreads();
}

__device__ __forceinline__ void p5_router(Frame& F) {
    LAS bf16_t* ht = (LAS bf16_t*)(F.lds);
    LAS bf16_t* wt = (LAS bf16_t*)(F.lds + 34816);
    LAS float* ssl = (LAS float*)(F.lds + 34816 + 17408);
    LAS int* hist = (LAS int*)(F.lds + 34816 + 17408 + 1024);
    LAS int* bas = (LAS int*)(F.lds + 34816 + 17408 + 1024 + 128);
    unsigned char* ws = F.ws; const int tid = F.tid, lane = F.lane, w = F.wave;
    int* tokslot = (int*)(ws + WS_MISC + M_TOKSLOT); int* slottok = (int*)(ws + WS_SLOTTOK); float* slotgate = (float*)(ws + WS_SLOTGATE); float* slotrs = (float*)(ws + WS_SLOTRS);
    unsigned* ctl = (unsigned*)(ws + WS_CTL);
    const bf16_t* H1 = (const bf16_t*)(ws + WS_H1); const bf16_t* wrt = (const bf16_t*)(ws + WS_MISC + M_WRT);
    float* rinv2 = (float*)(ws + WS_MISC + M_RINV2); int* topi = (int*)(ws + WS_MISC + M_TOPI); float* gate = (float*)(ws + WS_MISC + M_GATE); int* cnt = (int*)(ws + WS_MISC + M_CNT);
    const int rg = w & 3, kh = w >> 2, i = lane & 31, p = lane >> 5;
    for (int tile = F.vcu; tile < NTOK / 128; tile += F.G) {
        const int row0 = tile * 128;
        f32x16 acc;
#pragma unroll
        for (int r = 0; r < 16; ++r) acc[r] = 0.f;
        float ss = 0.f;
        u32x4 rh[4], rw[2];
#define P5_LOAD(kc_) do { _Pragma("unroll") for (int it = 0; it < 4; ++it) { const int idx = tid + it * NTHREADS, row = idx >> 4, c8 = idx & 15; rh[it] = *(const u32x4*)(H1 + (size_t)(row0 + row) * D + (kc_) * 128 + c8 * 8); } \
        _Pragma("unroll") for (int it = 0; it < 2; ++it) { const int idx = tid + it * NTHREADS, er = idx >> 4, c8 = idx & 15; rw[it] = *(const u32x4*)(wrt + (size_t)er * D + (kc_) * 128 + c8 * 8); } } while (0)
        P5_LOAD(0);
        for (int kc = 0; kc < 8; ++kc) {
            __syncthreads();
#pragma unroll
            for (int it = 0; it < 4; ++it) { const int idx = tid + it * NTHREADS, row = idx >> 4, c8 = idx & 15; *(LAS u32x4*)(ht + row * 136 + c8 * 8) = rh[it]; }
#pragma unroll
            for (int it = 0; it < 2; ++it) { const int idx = tid + it * NTHREADS, er = idx >> 4, c8 = idx & 15; *(LAS u32x4*)(wt + er * 136 + c8 * 8) = rw[it]; }
            __syncthreads();
            if (kc < 7) P5_LOAD(kc + 1);
#pragma unroll
            for (int s4 = 0; s4 < 4; ++s4) { const int ko = 64 * kh + 16 * s4 + 8 * p;
                const u32x4 av = *(const LAS u32x4*)(ht + (32 * rg + i) * 136 + ko);
                const bf16x8 a = __builtin_bit_cast(bf16x8, av), bh = *(const LAS bf16x8*)(wt + i * 136 + ko), bl = *(const LAS bf16x8*)(wt + (NE + i) * 136 + ko);
                f32x4 h0, h1; unpack8(av, h0, h1); ss += (h0[0] * h0[0] + h0[1] * h0[1]) + (h0[2] * h0[2] + h0[3] * h0[3]) + (h1[0] * h1[0] + h1[1] * h1[1]) + (h1[2] * h1[2] + h1[3] * h1[3]);
                acc = __builtin_amdgcn_mfma_f32_32x32x16_bf16(a, bh, acc, 0, 0, 0);
                acc = __builtin_amdgcn_mfma_f32_32x32x16_bf16(a, bl, acc, 0, 0, 0); }
        }
#undef P5_LOAD
        __syncthreads();
        LAS float* lgl = (LAS float*)(F.lds);
#pragma unroll
        for (int r = 0; r < 16; ++r) { const int row = 32 * rg + (r & 3) + 8 * (r >> 2) + 4 * p; lgl[(kh * 128 + row) * 33 + i] = acc[r]; }
        ss += __shfl_xor(ss, 32);
        if (p == 0) ssl[kh * 128 + 32 * rg + i] = ss;
        if (tid < 32) hist[tid] = 0;
        __syncthreads();
        i32x4 oi = {0, 0, 0, 0}; f32x4 og = {0.f, 0.f, 0.f, 0.f}; float ri = 0.f;
        if (tid < 128) {
            const int row = tid, t = row0 + row;
            ri = 1.0f / sqrtf((ssl[row] + ssl[128 + row]) * (1.0f / D) + RMS_EPS);
            float v[NE];
#pragma unroll
            for (int e = 0; e < NE; ++e) v[e] = (lgl[row * 33 + e] + lgl[(128 + row) * 33 + e]) * ri + F.router_b[e];
            float tv[TOPK]; int ti[TOPK];
#pragma unroll
            for (int k = 0; k < TOPK; ++k) { float best = -3.0e38f; int bi = 0;
#pragma unroll
                for (int e = 0; e < NE; ++e) { if (v[e] > best) { best = v[e]; bi = e; } }
                tv[k] = best; ti[k] = bi;
#pragma unroll
                for (int e = 0; e < NE; ++e) v[e] = (e == bi) ? -3.0e38f : v[e]; }
            float ex[TOPK], den = 0.f;
#pragma unroll
            for (int k = 0; k < TOPK; ++k) { ex[k] = __expf(tv[k] - tv[0]); den += ex[k]; }
            const float rden = 1.0f / den;
#pragma unroll
            for (int k = 0; k < TOPK; ++k) { const int rank = __hip_atomic_fetch_add(&hist[ti[k]], 1, __ATOMIC_RELAXED, __HIP_MEMORY_SCOPE_WORKGROUP); oi[k] = ti[k] | (rank << 8); og[k] = ex[k] * rden; }
            *(i32x4*)(topi + (size_t)t * 4) = oi; *(f32x4*)(gate + (size_t)t * 4) = og; rinv2[t] = ri;
        }
        __syncthreads();
        if (tid < 32) { const int h = hist[tid]; cnt[tile * 32 + tid] = h;
            int b = 0; if (h) b = (int)__hip_atomic_fetch_add(ctl + CTL_CURSOR + tid * CTL_CSTRIDE, (unsigned)h, __ATOMIC_RELAXED, __HIP_MEMORY_SCOPE_AGENT);
            bas[tid] = b; if (b + h > CAP) __hip_atomic_fetch_or(ctl + CTL_OVF, 1u, __ATOMIC_RELAXED, __HIP_MEMORY_SCOPE_AGENT); }
        __syncthreads();
        if (tid < 128) { const int t = row0 + tid; i32x4 so;
#pragma unroll
            for (int k = 0; k < TOPK; ++k) { const int e = oi[k] & 255, pos = bas[e] + (oi[k] >> 8), sl = e * ESTRIDE + pos; so[k] = sl;
                if (pos < CAP) { slottok[sl] = t; slotgate[sl] = og[k]; slotrs[sl] = MK_FP8 ? ri * (1.0f / (F8_SA * F8_SW)) : ri; } }
            *(i32x4*)(tokslot + (size_t)t * 4) = so; }
    }
    __syncthreads();
}

__device__ __forceinline__ void p6_scatter(Frame& F) {
    LAS int* cl = (LAS int*)(F.lds);
    LAS int* ps = (LAS int*)(F.lds + 32768);
    LAS int* tot = (LAS int*)(F.lds + 32768 + 2048);
    LAS int* pst = (LAS int*)(F.lds + 32768 + 2048 + 128);
    LAS int* bas = (LAS int*)(F.lds + 32768 + 2048 + 128 + 256);
    unsigned char* ws = F.ws; const int tid = F.tid;
    const int* cnt = (const int*)(ws + WS_MISC + M_CNT); const int* topi = (const int*)(ws + WS_MISC + M_TOPI); const float* gate = (const float*)(ws + WS_MISC + M_GATE); const float* rinv2 = (const float*)(ws + WS_MISC + M_RINV2);
    int* tokslot = (int*)(ws + WS_MISC + M_TOKSLOT); int* slottok = (int*)(ws + WS_SLOTTOK); float* slotgate = (float*)(ws + WS_SLOTGATE); float* slotrs = (float*)(ws + WS_SLOTRS);
    int* pstart_g = (int*)(ws + WS_MISC + M_PSTART); int* tile_e = (int*)(ws + WS_MISC + M_TILEE); int* ntiles_g = (int*)(ws + WS_MISC + M_NTILES);
    __syncthreads();
    for (int i = tid; i < 256 * 32; i += NTHREADS) cl[i] = cnt[i];
    __syncthreads();
    { const int e = tid & 31, part = tid >> 5; int s = 0;
#pragma unroll
      for (int j = 0; j < 16; ++j) s += cl[(part * 16 + j) * 32 + e];
      ps[part * 32 + e] = s; }
    __syncthreads();
    if (tid < 32) { int s = 0;
#pragma unroll
        for (int j = 0; j < 16; ++j) s += ps[j * 32 + tid];
        tot[tid] = s; }
    __syncthreads();
    if (tid == 0) { int a = 0; for (int e = 0; e < NE; ++e) { pst[e] = a; a += (tot[e] + 255) & ~255; } pst[NE] = a; }
    __syncthreads();
    if (F.vcu == 0) {
        const int nt = pst[NE] >> 8;
        if (tid == 0) ntiles_g[0] = nt;
        if (tid <= NE) pstart_g[tid] = pst[tid];
        for (int mt = tid; mt < MAXTILES; mt += NTHREADS) { int e = 0;
#pragma unroll
            for (int j = 1; j < NE; ++j) e += (pst[j] <= mt * 256) ? 1 : 0;
            tile_e[mt] = e; }
    }
    if (F.vcu < NE) {
        const int e = F.vcu; for (int s = pst[e] + tot[e] + tid; s < pst[e + 1]; s += NTHREADS) { slottok[s] = 0; slotgate[s] = 0.f; slotrs[s] = 0.f; }
    }
    for (int tile = F.vcu; tile < NTOK / 128; tile += F.G) {
        __syncthreads();
        if (tid < 32) { const int part = tile >> 4; int s = 0; for (int j = 0; j < part; ++j) s += ps[j * 32 + tid]; for (int t2 = part * 16; t2 < tile; ++t2) s += cl[t2 * 32 + tid]; bas[tid] = pst[tid] + s; }
        __syncthreads();
        if (tid < 128) { const int t = tile * 128 + tid; const i32x4 ti = *(const i32x4*)(topi + (size_t)t * 4); const f32x4 g = *(const f32x4*)(gate + (size_t)t * 4); const float ri = rinv2[t]; i32x4 so;
#pragma unroll
            for (int k = 0; k < TOPK; ++k) { const int e = ti[k] & 255, rank = ti[k] >> 8, s = bas[e] + rank; so[k] = s; slottok[s] = t; slotgate[s] = g[k]; slotrs[s] = MK_FP8 ? ri * (1.0f / (F8_SA * F8_SW)) : ri; }
            *(i32x4*)(tokslot + (size_t)t * 4) = so; }
    }
    __syncthreads();
}

__device__ __forceinline__ void p9_final(Frame& F) {
    unsigned char* ws = F.ws; const int lane = F.lane; const int gw = F.vcu * NWAVES + F.wave, NGW = F.G * NWAVES;
    const bf16_t* H1 = (const bf16_t*)(ws + WS_H1); const bf16_t* YC = (const bf16_t*)(ws + WS_YC); const int* tokslot = (const int*)(ws + WS_MISC + M_TOKSLOT);
    f32x4 gf[4];
#pragma unroll
    for (int j = 0; j < 4; ++j) gf[j] = *(const f32x4*)(F.gf + 4 * lane + 256 * j);
    for (int t = gw; t < NTOK; t += NGW) {
        const i32x4 sl = *(const i32x4*)(tokslot + (size_t)t * 4);
        f32x4 h[4];
#pragma unroll
        for (int j = 0; j < 4; ++j) { const u32x2 wv = *(const u32x2*)(H1 + (size_t)t * D + 4 * lane + 256 * j); h[j] = (f32x4){bf_lo(wv.x), bf_hi(wv.x), bf_lo(wv.y), bf_hi(wv.y)}; }
#pragma unroll
        for (int k = 0; k < TOPK; ++k) {
            if (MK_FP8) { const unsigned char* yr = (const unsigned char*)YC + (size_t)sl[k] * D;
#pragma unroll
                for (int j = 0; j < 4; ++j) { const int wv = *(const int*)(yr + 4 * lane + 256 * j); const f32v2_t lo = __builtin_amdgcn_cvt_pk_f32_fp8(wv, false), hi = __builtin_amdgcn_cvt_pk_f32_fp8(wv, true);
                    h[j] += (f32x4){lo.x, lo.y, hi.x, hi.y} * (1.0f / F8_SY); }
            } else { const bf16_t* yr = YC + (size_t)sl[k] * D;
#pragma unroll
                for (int j = 0; j < 4; ++j) { const u32x2 wv = *(const u32x2*)(yr + 4 * lane + 256 * j); h[j] += (f32x4){bf_lo(wv.x), bf_hi(wv.x), bf_lo(wv.y), bf_hi(wv.y)}; } } }
        float s = 0.f;
#pragma unroll
        for (int j = 0; j < 4; ++j) s += (h[j][0] * h[j][0] + h[j][1] * h[j][1]) + (h[j][2] * h[j][2] + h[j][3] * h[j][3]);
        const float ri = 1.0f / sqrtf(wave_sum(s) * (1.0f / D) + RMS_EPS);
#pragma unroll
        for (int j = 0; j < 4; ++j) __builtin_nontemporal_store(h[j] * ri * gf[j], (f32x4*)(F.out + (size_t)t * D + 4 * lane + 256 * j));
    }
}

#ifndef MK_SP2
#define MK_SP2 true
#endif
#ifndef MK_ALIGN
#define MK_ALIGN true
#endif
constexpr int NPHASES = 10;
#ifndef MK_PHASE_MASK
#define MK_PHASE_MASK 0x3ff
#endif

__global__ void __launch_bounds__(NTHREADS, 2) fwd_kernel(Args args) {
    extern __shared__ __attribute__((aligned(16))) unsigned char lds[];
    cg::grid_group grid = cg::this_grid();
    Frame F;
    F.lds = (LAS unsigned char*)lds;
    F.tid = threadIdx.x; F.lane = F.tid & 63; F.wave = __builtin_amdgcn_readfirstlane(F.tid >> 6);
    F.G = gridDim.x; { const int bx = blockIdx.x; F.vcu = (F.G % 8 == 0) ? (bx % 8) * (F.G / 8) + bx / 8 : bx; }
    F.x = args.in[0]; F.meta = args.in[1]; F.g1 = args.in[2]; F.w_in = args.in[3]; F.b_in = args.in[4]; F.w_pool = args.in[5]; F.pool_scale = args.in[6]; F.w_dw = args.in[7]; F.b_dw = args.in[8];
    F.ln_g = args.in[9]; F.ln_b = args.in[10]; F.w_pw2 = args.in[11]; F.b_pw2 = args.in[12]; F.w_out = args.in[13]; F.g2 = args.in[14]; F.router_w = args.in[15]; F.router_b = args.in[16];
    F.w_gu = args.in[17]; F.b_gu = args.in[18]; F.w_dn = args.in[19]; F.b_dn = args.in[20]; F.gf = args.in[21];
    F.out = args.out; F.ws = args.ws;
    unsigned char* ws = args.ws;
    const int lo = args.ph_lo, hi = args.ph_hi;
#define IN(k) (((MK_PHASE_MASK >> (k)) & 1) && lo <= (k) && (k) < hi)
    volatile LAS unsigned* bst = (volatile LAS unsigned*)(F.lds + LDS_BYTES - 64);
    if (F.tid < 2) bst[F.tid] = 0u;
    __syncthreads();
    XcdBarrier bar = xcd_barrier_post((unsigned*)(ws + WS_CTL) + 4096 + args.bar_region * XCD_BAR_WORDS, bst);
#ifndef MK_CG_SEAMS
#define MK_CG_SEAMS 0x0
#endif
#ifndef MK_FILL
#define MK_FILL 2
#endif
#define SEAM(k) do { if (IN(k) && IN((k) + 1)) { if ((MK_CG_SEAMS >> (k)) & 1) grid.sync(); else xcd_barrier(bar); } } while (0)
    unsigned* const barA = (unsigned*)(ws + WS_CTL) + 4096 + args.bar_region * XCD_BAR_WORDS; unsigned* const barB = (unsigned*)(ws + WS_CTL) + 4096 + 2 * XCD_BAR_WORDS; unsigned nsplit = 0u;
#define SEAMF(k, j0, j1) do { if (IN(k) && IN((k) + 1)) { if ((j1) > (j0)) { xcd_arrive2(barA, barB, bar); p0b_expert_weights(F.lds, F.vcu, F.G, F.wave, F.lane, (j0), (j1)); xcd_wait2(barA, barB, nsplit); ++nsplit; } else xcd_barrier(bar); } } while (0)
    const int bid = (int)blockIdx.x;

    if (IN(0)) p0_prologue(F);
    SEAMF(0, 0 * MK_FILL, 1 * MK_FILL);
    if (IN(1)) {
        p1_meta_finish(F);
        const bool conv_first = ((bid >> 3) & 1) == 0;
        if (conv_first) { p0b_expert_weights(F.lds, F.vcu, F.G, F.wave, F.lane, 5 * MK_FILL, P0B_NJ); __syncthreads(); }
        {
            pg8::DenseSched S; S.init(NTOK, 1536, F.G, bid); S.A = (const char*)(ws + WS_XB); S.B = (const char*)(ws + WS_W1T); S.a_tile = (size_t)256 * D * 2; S.a_pn = 0; S.b_tile = (size_t)256 * D * 2;
            EpiIn<false> E{(const float*)(ws + WS_MISC + M_RINV1), F.b_in, (bf16_t*)(ws + WS_U), (bf16_t*)(ws + WS_A), (bf16_t*)(ws + WS_GA), (bf16_t*)(ws + WS_GB)};
            int kq = D; asm volatile("" : "+s"(kq));
            pg8::gemm_phase<EpiIn<false>, pg8::DenseSched, false, MK_ALIGN, MK_SP2, false, false, true, false, (MK_KROT & 1) != 0>(F.lds, kq, D, D, S, E);
        }
        {
            pg8::DenseSched S; S.init(NTOK, 2048, F.G, bid); S.A = (const char*)(ws + WS_XQ8); S.B = (const char*)(ws + WS_W1G8); S.a_tile = (size_t)256 * D; S.a_pn = 0; S.b_tile = (size_t)256 * D;
            EpiIn<true> E{(const float*)(ws + WS_MISC + M_RINV1), F.b_in, (bf16_t*)(ws + WS_U), (bf16_t*)(ws + WS_A), (bf16_t*)(ws + WS_GA), (bf16_t*)(ws + WS_GB)};
            int kq = D / 2; asm volatile("" : "+s"(kq));
            pg8::gemm_phase<EpiIn<true>, pg8::DenseSched, false, MK_ALIGN, MK_SP2, true, false, true, false, (MK_KROT & 2) != 0>(F.lds, kq, D / 2, D / 2, S, E);
        }
        if (!conv_first) p0b_expert_weights(F.lds, F.vcu, F.G, F.wave, F.lane, 5 * MK_FILL, P0B_NJ);
    }
    SEAMF(1, 1 * MK_FILL, 2 * MK_FILL);
    if (IN(2)) p2_mixer_pre(F);
    SEAMF(2, 2 * MK_FILL, 3 * MK_FILL);
    if (IN(3)) {
        pg8::DenseSched S; S.init(NTOK, D, F.G, bid); S.A = (const char*)(ws + WS_DP); S.B = (const char*)(ws + WS_WPT); S.a_tile = (size_t)256 * D * 2; S.a_pn = 128 * 2; S.b_tile = (size_t)256 * 640 * 2;
        EpiMix E{(const unsigned char*)(ws + WS_GA), (const unsigned char*)(ws + WS_GB), F.b_pw2, (bf16_t*)(ws + WS_MIXED)};
        int kp = 640; asm volatile("" : "+s"(kp));
        pg8::gemm_phase<EpiMix, pg8::DenseSched, false, MK_ALIGN, MK_SP2, false, true>(F.lds, kp, D, 640, S, E);
    }
    SEAMF(3, 3 * MK_FILL, 4 * MK_FILL);
    if (IN(4)) {
        pg8::DenseSched S; S.init(NTOK, D, F.G, bid); S.A = (const char*)(ws + WS_MIXED); S.B = (const char*)(ws + WS_OUTT); S.a_tile = (size_t)256 * D * 2; S.a_pn = 0; S.b_tile = (size_t)256 * D * 2;
        EpiOut E{(const bf16_t*)(ws + WS_XB), (bf16_t*)(ws + WS_H1), (bf16_t*)(ws + WS_H1B)};
        pg8::gemm_phase<EpiOut, pg8::DenseSched, false, MK_ALIGN, MK_SP2, false, false, false, false, (MK_KROT & 8) != 0>(F.lds, D, D, D, S, E);
    }
    SEAMF(4, 4 * MK_FILL, 5 * MK_FILL);
    if (IN(5)) p5_router(F);
    SEAM(5);
    const bool ovf = MK_FORCE_OVF || (__builtin_amdgcn_readfirstlane(((const unsigned*)(ws + WS_CTL))[CTL_OVF]) != 0u);
    if (IN(6) && ovf) { p6_scatter(F); if (IN(7)) xcd_barrier(bar); }
    if (IN(7) || IN(8)) {
        LAS int* tl = (LAS int*)(F.lds + LDS_TILEE_OFF); LAS int* ntl = (LAS int*)(F.lds + LDS_NTILES_OFF);
        __syncthreads();
        if (ovf) {
            const int nt = *(const int*)(ws + WS_MISC + M_NTILES);
            for (int i = F.tid; i < MAXTILES; i += NTHREADS) tl[i] = i | (((const int*)(ws + WS_MISC + M_TILEE))[i] << 11) | (256 << 16);
            if (F.tid == 0) ntl[0] = nt;
        } else {
            if (F.tid == 0) { int a = 0; for (int e = 0; e < NE; ++e) { ntl[1 + e] = a; a += ((int)((const unsigned*)(ws + WS_CTL))[CTL_CURSOR + e * CTL_CSTRIDE] + 255) >> 8; } ntl[0] = a; }
            __syncthreads();
            { const int e = F.tid >> 4; const int n = (int)((const unsigned*)(ws + WS_CTL))[CTL_CURSOR + e * CTL_CSTRIDE], nte = (n + 255) >> 8, b0 = ntl[1 + e];
              for (int v = F.tid & 15; v < nte; v += 16) { const int valid = (n - v * 256) < 256 ? (n - v * 256) : 256; tl[b0 + v] = (e * (ESTRIDE / 256) + v) | (e << 11) | (valid << 16); } }
        }
        __syncthreads();
    }
    if (IN(7)) {
        const int ntiles = __builtin_amdgcn_readfirstlane(*(const LAS int*)(F.lds + LDS_NTILES_OFF));
        constexpr int EB = MK_FP8 ? 1 : 2;
        pg8::MoeSched S; S.nunits = ntiles * 8; S.npn = 8; S.G = F.G; S.c = bid; S.A = (const char*)(ws + (MK_FP8 ? WS_H1B : WS_H1)); S.B = (const char*)(ws + WS_GUT); S.rows_ = (const int*)(ws + WS_SLOTTOK);
        S.tile_e = (const LAS int*)(F.lds + LDS_TILEE_OFF); S.a_tile = 0; S.e_bytes = (size_t)2 * DE * D * EB; S.pn_bytes = (size_t)256 * D * EB;
        EpiUp E{(const LAS int*)(F.lds + LDS_TILEE_OFF), (const float*)(ws + WS_SLOTRS), F.b_gu, (bf16_t*)(ws + WS_ACT)};
        int kq = D * EB / 2; asm volatile("" : "+s"(kq));
        pg8::gemm_phase<EpiUp, pg8::MoeSched, true, MK_ALIGN, MK_SP2, MK_FP8, false, true, MK_HALFU != 0, (MK_KROT & 16) != 0>(F.lds, kq, D * EB / 2, D * EB / 2, S, E);
    }
    SEAM(7);
    if (IN(8)) {
        const int ntiles = __builtin_amdgcn_readfirstlane(*(const LAS int*)(F.lds + LDS_NTILES_OFF));
        constexpr int EB = MK_FP8 ? 1 : 2;
        pg8::MoeSched S; S.nunits = ntiles * 4; S.npn = 4; S.G = F.G; S.c = bid; S.A = (const char*)(ws + WS_ACT); S.B = (const char*)(ws + WS_DNT); S.rows_ = nullptr;
        S.tile_e = (const LAS int*)(F.lds + LDS_TILEE_OFF); S.a_tile = (size_t)256 * DE * EB; S.e_bytes = (size_t)D * DE * EB; S.pn_bytes = (size_t)256 * DE * EB;
        EpiDown E{(const LAS int*)(F.lds + LDS_TILEE_OFF), (const float*)(ws + WS_SLOTGATE), F.b_dn, (bf16_t*)(ws + WS_YC)};
        int kq = DE * EB / 2; asm volatile("" : "+s"(kq));
        pg8::gemm_phase<EpiDown, pg8::MoeSched, false, MK_ALIGN, MK_SP2, MK_FP8, false, true, MK_HALFU != 0, (MK_KROT & 32) != 0>(F.lds, kq, DE * EB / 2, DE * EB / 2, S, E);
    }
    SEAM(8);
    if (IN(9)) p9_final(F);
#undef IN
#undef SEAM
}


extern "C" void kernel_launch(void* const* d_in, const int* in_sizes, int n_in, void* d_out, int out_size, void* d_ws, size_t ws_size, hipStream_t stream) {
    static int grid = 0;
    if (grid == 0) {
        if (n_in != 22 || out_size != NTOK * D || ws_size < WS_END) { fprintf(stderr, "kernel_launch: unexpected shapes (n_in %d out %d ws %zu)\n", n_in, out_size, ws_size); grid = -1; return; }
        int dev = 0, cus = 0, per_cu = 0;
        if (hipGetDevice(&dev) != hipSuccess || hipDeviceGetAttribute(&cus, hipDeviceAttributeMultiprocessorCount, dev) != hipSuccess) { grid = -1; return; }
        if (hipFuncSetAttribute((const void*)fwd_kernel, hipFuncAttributeMaxDynamicSharedMemorySize, LDS_BYTES) != hipSuccess) { fprintf(stderr, "kernel_launch: hipFuncSetAttribute failed\n"); grid = -1; return; }
        if (hipOccupancyMaxActiveBlocksPerMultiprocessor(&per_cu, (const void*)fwd_kernel, NTHREADS, LDS_BYTES) != hipSuccess || per_cu < 1) { fprintf(stderr, "kernel_launch: occupancy query says %d\n", per_cu); grid = -1; return; }
        grid = cus * 1;
    }
    if (grid < 0) return;
    if (hipMemsetAsync((char*)d_ws + WS_CTL, 0, 65536, stream) != hipSuccess) { fprintf(stderr, "kernel_launch: memset failed\n"); return; }
    Args a{};
    for (int i = 0; i < 22; ++i) a.in[i] = (const float*)d_in[i];
    a.out = (float*)d_out; a.ws = (unsigned char*)d_ws;
#ifndef MK_PROBE_LO
#define MK_PROBE_LO -1
#define MK_PROBE_HI -1
#endif
    const int cuts[4][2] = {{0, MK_PROBE_LO < 0 ? NPHASES : MK_PROBE_HI}, {MK_PROBE_LO, MK_PROBE_HI}, {MK_PROBE_HI, NPHASES}, {0, 0}};
    const int nl = MK_PROBE_LO < 0 ? 1 : (MK_PROBE_HI < NPHASES ? 3 : 2);
    for (int li = 0; li < nl; ++li) {
        a.ph_lo = cuts[li][0]; a.ph_hi = cuts[li][1]; a.bar_region = li;
        void* kargs[] = {&a};
        hipError_t e = hipLaunchCooperativeKernel((const void*)fwd_kernel, dim3(grid), dim3(NTHREADS), kargs, LDS_BYTES, stream);
        if (e != hipSuccess) fprintf(stderr, "cooperative launch failed: %s (grid %d)\n", hipGetErrorString(e), grid);
    }
}
```

```cpp
#include <hip/hip_runtime.h>
#include <hip/hip_cooperative_groups.h>
#include <cstdio>
#include <cstdint>
namespace cg = cooperative_groups;

#define GAS __attribute__((address_space(1)))
#define LAS __attribute__((address_space(3)))
typedef unsigned short bf16_t;
typedef short bf16x8 __attribute__((ext_vector_type(8)));
typedef float f32x4 __attribute__((ext_vector_type(4)));
typedef float f32x16 __attribute__((ext_vector_type(16)));
typedef unsigned u32x4 __attribute__((ext_vector_type(4)));
typedef unsigned u32x2 __attribute__((ext_vector_type(2)));
typedef int i32x4 __attribute__((ext_vector_type(4)));

constexpr int NB = 8, SEQ = 4096, D = 1024, NTOK = NB * SEQ;
constexpr int NMETA = 16, PW = 512, CW = 512, NCOL1 = 3584, CK = 31;
constexpr int NE = 32, TOPK = 4, DE = 1024;
constexpr int NASSIGN = NTOK * TOPK, MAXTILES = NASSIGN / 256 + NE, NSLOT = MAXTILES * 256;
constexpr int CAP = 8192, ESTRIDE = CAP + 256, NSLOTX = NE * ESTRIDE;
constexpr int CTL_CURSOR = 64, CTL_CSTRIDE = 64, CTL_OVF = 32;
#ifndef MK_FORCE_OVF
#define MK_FORCE_OVF 0
#endif
constexpr float RMS_EPS = 1e-5f, LN_EPS = 1e-5f, SW_LIMIT = 7.0f, SW_ALPHA = 1.702f;
constexpr int NWAVES = 8, NTHREADS = 512;
constexpr int LDS_BYTES = 163840;
constexpr int LDS_TILEE_OFF = 131072, LDS_EPI_OFF = 135168, LDS_EPI_BUF = 2048, LDS_NTILES_OFF = LDS_TILEE_OFF + 4 * 600;
#ifndef MK_FP8
#define MK_FP8 1
#endif
constexpr float F8_SA = 16.0f, F8_SW = 1024.0f, F8_SACT = 4.0f, F8_SY = 32.0f;

constexpr size_t MiB = 1u << 20;
constexpr size_t WS_CTL = 0, CTL_ZERO_BYTES = 1 * MiB;
constexpr size_t WS_MISC = 1 * MiB;
constexpr size_t M_RINV1 = 0, M_RINV2 = 131072, M_METAP = 262144, M_METAR = 1048576, M_UMETA = 1048832, M_AMETA = 1065216, M_CNT = 1081600,
                 M_PSTART = 1114368, M_TILEE = 1114624, M_NTILES = 1116928, M_TOPI = 1117184, M_GATE = 1641472, M_TOKSLOT = 2165760,
                 M_SLOTTOK = 2690048, M_SLOTGATE = 3247104, M_SLOTRS = 3804160, M_END = 4361216;
constexpr size_t M_WRT = 5 * MiB;
static_assert(M_END <= M_WRT && M_WRT + 2 * 32 * 1024 * 2 <= 8 * MiB, "misc");
constexpr size_t WS_W1T = 9 * MiB, WS_WPT = 16 * MiB, WS_PW2T = 16 * MiB + 512 * 1024, WS_OUTT = 18 * MiB, WS_GUT = 20 * MiB, WS_DNT = 148 * MiB;
constexpr size_t WS_H1 = 212 * MiB;
constexpr size_t WS_SLOTTOK = 276 * MiB, WS_SLOTGATE = 278 * MiB, WS_SLOTRS = 280 * MiB;
constexpr size_t WS_METAP = WS_H1;
constexpr size_t WS_R1 = 340 * MiB;
constexpr size_t WS_XB = WS_R1, WS_U = WS_R1 + 64 * MiB, WS_A = WS_R1 + 96 * MiB, WS_GA = WS_R1 + 128 * MiB, WS_GB = WS_R1 + 192 * MiB, WS_DP = WS_R1 + 256 * MiB, WS_SC = WS_R1 + 288 * MiB;
constexpr size_t WS_ACT = WS_R1;
constexpr size_t WS_R2 = 660 * MiB;
constexpr size_t WS_MIXED = WS_R2, WS_H1B = WS_R2 + 64 * MiB;
constexpr size_t WS_XQ8 = WS_R2 + 128 * MiB;
constexpr size_t WS_W1G8 = WS_W1T + (size_t)1536 * D * 2;
constexpr size_t WS_YC = WS_R2;
constexpr size_t WS_END = 932 * MiB;
static_assert(WS_SC == WS_DP + 32 * MiB && WS_PW2T + (size_t)D * 640 * 2 > WS_WPT + (size_t)D * 640 * 2 - 1, "combined buffers");
static_assert(MK_FP8 && WS_ACT + (size_t)NSLOTX * 1024 <= WS_R2 && WS_YC + (size_t)NSLOTX * 1024 <= WS_END && NSLOT <= NSLOTX && WS_SLOTRS + (size_t)NSLOTX * 4 <= WS_R1, "ws map");

#define LDS_WAIT() asm volatile("s_waitcnt lgkmcnt(0)" ::: "memory")
#define VM_WAIT() asm volatile("s_waitcnt vmcnt(0)" ::: "memory")
typedef __bf16 bf16v2_t __attribute__((ext_vector_type(2)));
typedef float f32v2_t __attribute__((ext_vector_type(2)));
__device__ __forceinline__ unsigned cvt_pk_bf16(float lo, float hi) { const f32v2_t f = {lo, hi}; const bf16v2_t b = __builtin_convertvector(f, bf16v2_t); return __builtin_bit_cast(unsigned, b); }
__device__ __forceinline__ float bf_lo(unsigned w) { return __uint_as_float(w << 16); }
__device__ __forceinline__ float bf_hi(unsigned w) { return __uint_as_float(w & 0xffff0000u); }
__device__ __forceinline__ float sigmoidf_(float x) { return __builtin_amdgcn_rcpf(1.0f + __builtin_amdgcn_exp2f(x * -1.44269504f)); }
__device__ __forceinline__ float wave_sum(float v) {
#pragma unroll
    for (int o = 1; o < 64; o <<= 1) v += __shfl_xor(v, o);
    return v;
}
__device__ __forceinline__ float clamp448(float v) { return fminf(fmaxf(v, -448.0f), 448.0f); }
__device__ __forceinline__ unsigned pack4_fp8(float a, float b, float c, float d) { int w = __builtin_amdgcn_cvt_pk_fp8_f32(clamp448(a), clamp448(b), 0, false); w = __builtin_amdgcn_cvt_pk_fp8_f32(clamp448(c), clamp448(d), w, true); return (unsigned)w; }
__device__ __forceinline__ unsigned pack4_fp8_nc(float a, float b, float c, float d) { int w = __builtin_amdgcn_cvt_pk_fp8_f32(a, b, 0, false); w = __builtin_amdgcn_cvt_pk_fp8_f32(c, d, w, true); return (unsigned)w; }
__device__ __forceinline__ u32x2 pack8_fp8_nc(const f32x4 a, const f32x4 b, float sc) { u32x2 w; w.x = pack4_fp8_nc(a[0] * sc, a[1] * sc, a[2] * sc, a[3] * sc); w.y = pack4_fp8_nc(b[0] * sc, b[1] * sc, b[2] * sc, b[3] * sc); return w; }
__device__ __forceinline__ u32x2 pack8_fp8(const f32x4 a, const f32x4 b, float sc) { u32x2 w; w.x = pack4_fp8(a[0] * sc, a[1] * sc, a[2] * sc, a[3] * sc); w.y = pack4_fp8(b[0] * sc, b[1] * sc, b[2] * sc, b[3] * sc); return w; }
__device__ __forceinline__ unsigned pack4_u8(const f32x4 a) {
    const unsigned b0 = (unsigned)(a[0] * 255.0f + 0.5f), b1 = (unsigned)(a[1] * 255.0f + 0.5f), b2 = (unsigned)(a[2] * 255.0f + 0.5f), b3 = (unsigned)(a[3] * 255.0f + 0.5f);
    return b0 | (b1 << 8) | (b2 << 16) | (b3 << 24); }
__device__ __forceinline__ f32x4 unpack4_u8(unsigned w) { return (f32x4){(float)(w & 0xffu), (float)((w >> 8) & 0xffu), (float)((w >> 16) & 0xffu), (float)(w >> 24)} * (1.0f / 255.0f); }
__device__ __forceinline__ u32x4 widen_pair(const u32x2 pa, const u32x2 pb, const int fq) {
    const bool odd = (fq & 1) != 0; const u32x2 send = odd ? pa : pb, keep = odd ? pb : pa;
    u32x2 got; got.x = (unsigned)__shfl_xor((int)send.x, 16); got.y = (unsigned)__shfl_xor((int)send.y, 16);
    return odd ? (u32x4){got.x, got.y, keep.x, keep.y} : (u32x4){keep.x, keep.y, got.x, got.y};
}
__device__ __forceinline__ u32x4 pack8(const f32x4 a, const f32x4 b) { u32x4 w; w.x = cvt_pk_bf16(a[0], a[1]); w.y = cvt_pk_bf16(a[2], a[3]); w.z = cvt_pk_bf16(b[0], b[1]); w.w = cvt_pk_bf16(b[2], b[3]); return w; }
__device__ __forceinline__ void unpack8(const u32x4 w, f32x4& a, f32x4& b) { a = (f32x4){bf_lo(w.x), bf_hi(w.x), bf_lo(w.y), bf_hi(w.y)}; b = (f32x4){bf_lo(w.z), bf_hi(w.z), bf_lo(w.w), bf_hi(w.w)}; }

#ifndef MK_KROT
#define MK_KROT 50
#endif
#ifndef MK_HALFU
#define MK_HALFU 1
#endif
namespace pg8 {
constexpr int BM = 256, BK = 64, HALF = 128, HTB = HALF * BK * 2, STAGE_BYTES = 8 * HTB, NXCD = 8, WGM = 8;
__host__ __device__ __forceinline__ int lds_byte(int r, int c) { const int st = (r >> 4) * 2 + (c >> 5), rr = r & 15, cc = c & 31, ob = rr * 64 + cc * 2; return st * 1024 + (ob ^ (((ob >> 9) & 1) << 5)); }
__host__ __device__ __forceinline__ void stage_rc(int b, int& R, int& C) { const int st = b / 1024, sb = b % 1024, swz = sb ^ (((sb >> 9) & 1) << 5); R = (st >> 1) * 16 + swz / 64; C = (st & 1) * 32 + (swz % 64) / 2; }
__host__ __device__ __forceinline__ int perm32(int rho) { const int n = rho >> 4, i = rho & 15; return 8 * (i >> 2) + 4 * n + (i & 3); }

struct Unit { int pm, pn, pe, pv, ph; };
typedef int i32x8_t __attribute__((ext_vector_type(8)));
typedef int i32x4_t __attribute__((ext_vector_type(4)));
__device__ __forceinline__ void mfma_fp8(f32x4& c, const i32x8_t a, const i32x8_t b, const int one) {
    asm volatile("v_mfma_scale_f32_16x16x128_f8f6f4 %0, %1, %2, %0, %3, %3 op_sel_hi:[0,0,0]" : "+v"(c) : "v"(a), "v"(b), "v"(one));
}
__device__ __forceinline__ i32x8_t cat8(const bf16x8 a, const bf16x8 b) { const i32x4_t x = __builtin_bit_cast(i32x4_t, a), y = __builtin_bit_cast(i32x4_t, b); return __builtin_shufflevector(x, y, 0, 1, 2, 3, 4, 5, 6, 7); }

struct DenseSched {
    int nM, nN, nwg, G, c; const char* A; const char* B; size_t a_tile, a_pn, b_tile;
    __device__ __forceinline__ void init(int M, int N, int G_, int c_) { nM = M / BM; nN = N / BM; nwg = nM * nN; G = G_; c = c_; }
    __device__ __forceinline__ bool next(int i, Unit& u) const {
        const long L = (long)i * G + c; if (L >= nwg) return false;
        int wgid = (int)L; { const int q = nwg / NXCD, r = nwg % NXCD, xcd = wgid % NXCD, off = wgid / NXCD; wgid = (xcd < r ? xcd * (q + 1) : r * (q + 1) + (xcd - r) * q) + off; }
        const int nig = WGM * nN, gid = wgid / nig, fm = gid * WGM, gsz = (nM - fm) < WGM ? (nM - fm) : WGM;
        u.pm = fm + ((wgid % nig) % gsz); u.pn = (wgid % nig) / gsz; u.ph = 0; return true;
    }
    __device__ __forceinline__ const char* a_ptr(const Unit& u) const { return A + (size_t)u.pm * a_tile + (size_t)u.pn * a_pn; }
    __device__ __forceinline__ const char* b_ptr(const Unit& u) const { return B + (size_t)u.pn * b_tile; }
    __device__ __forceinline__ const int* rows(const Unit&) const { return nullptr; }
    __device__ __forceinline__ size_t a_skip(const Unit& u) const { return (size_t)(384 - 128 * u.pn) * 2; }
    __device__ __forceinline__ int koff(const Unit& u, int nt) const { return 2 * ((u.pm + u.pn) % (nt >> 1)); }
};
struct MoeSched {
    int nunits, npn, G, c; const char* A; const char* B; const int* rows_; const LAS int* tile_e; size_t a_tile, e_bytes, pn_bytes;
    __device__ __forceinline__ bool next(int i, Unit& u) const {
        int wgid, ph = 0;
        if ((G & 7) == 0) {
            const int W = G >> 3, xcd = c & 7, j = c >> 3, q = nunits >> 3, rq = nunits & 7;
            const int qx = q + (xcd < rq ? 1 : 0), start = xcd * q + (xcd < rq ? xcd : rq), Rx = qx / W, rx = qx - Rx * W;
            if (i < Rx) wgid = start + i * W + j;
            else if (i == Rx && rx > 0) {
                if (MK_HALFU && 2 * rx <= W) { if (j >= 2 * rx) return false; wgid = start + Rx * W + (j >> 1); ph = 1 + (j & 1); }
                else { if (j >= rx) return false; wgid = start + Rx * W + j; }
            } else return false;
        } else {
            const long L = (long)i * G + c; if (L >= nunits) return false;
            wgid = (int)L; { const int q = nunits / NXCD, r = nunits % NXCD, xcd = wgid % NXCD, off = wgid / NXCD; wgid = (xcd < r ? xcd * (q + 1) : r * (q + 1) + (xcd - r) * q) + off; }
        }
        u.ph = ph;
        const int ent = __builtin_amdgcn_readfirstlane(tile_e[wgid / npn]);
        u.pm = ent & 2047; u.pe = (ent >> 11) & 31; u.pv = ent >> 16; u.pn = wgid % npn; return true;
    }
    __device__ __forceinline__ const char* a_ptr(const Unit& u) const { return A + (size_t)u.pm * a_tile; }
    __device__ __forceinline__ const char* b_ptr(const Unit& u) const { return B + (size_t)u.pe * e_bytes + (size_t)u.pn * pn_bytes; }
    __device__ __forceinline__ const int* rows(const Unit& u) const { return rows_ + (size_t)u.pm * BM; }
    __device__ __forceinline__ size_t a_skip(const Unit&) const { return 0; }
    __device__ __forceinline__ int koff(const Unit& u, int nt) const { return 2 * (u.pn % (nt >> 1)); }
};

template <class Epi, class Sched, bool GATHER, bool ALIGN_EPI, bool SP2, bool FP8 = false, bool CATK = false, bool EPF = false, bool HALFU = false, bool KROT = false>
__device__ __forceinline__ void gemm_phase(LAS unsigned char* lds, const int K, const int lda, const int ldb, const Sched& S, const Epi& E) {
    const int tid = threadIdx.x, wid = __builtin_amdgcn_readfirstlane(tid >> 6), lane = tid & 63, wr = wid >> 2, wc = wid & 3, fr = lane & 15, fq = lane >> 4;
    const int nt = K / BK;
    int Rr[2], Cc[2]; unsigned voffA[2], voffB[2];
#pragma unroll
    for (int i = 0; i < 2; ++i) { stage_rc(tid * 16 + i * 8192, Rr[i], Cc[i]); const int Rb = (Rr[i] & ~31) + perm32(Rr[i] & 31);
        voffA[i] = (unsigned)(Rr[i] * lda + Cc[i]) * 2u; voffB[i] = (unsigned)(Rb * ldb + Cc[i]) * 2u; }
    const size_t kstep = (size_t)(BK * 2);
    const size_t hstepA = (size_t)HALF * lda * 2, hstepB = (size_t)HALF * ldb * 2;
    const unsigned lda2 = (unsigned)lda * 2u;
    const unsigned ldsw = (unsigned)wid * 1024u;
    const int aoff = lds_byte(wr * 64 + fr, fq * 8), boff = lds_byte(wc * 32 + fr, fq * 8);
#define PG8_SA(b, h) (((b) * 2 + (h)) * HTB)
#define PG8_SB(b, h) ((4 + (b) * 2 + (h)) * HTB)
#define PG8_ST2(bufoff, gbase, o0, o1) do { \
        __builtin_amdgcn_global_load_lds((const unsigned*)((const char*)(gbase) + (o0)), (LAS unsigned*)(lds + (bufoff) + ldsw), 16, 0, 0); \
        __builtin_amdgcn_global_load_lds((const unsigned*)((const char*)(gbase) + (o1)), (LAS unsigned*)(lds + (bufoff) + ldsw + 8192), 16, 0, 0); } while (0)
#define PG8_STB(bufoff, gbase) PG8_ST2(bufoff, gbase, voffB[0], voffB[1])
#define PG8_STA(bufoff, ubase, H, G0, G1) do { if constexpr (GATHER) { PG8_ST2(bufoff, ubase, G0, G1); } else { PG8_ST2(bufoff, (ubase) + (H) * hstepA, voffA[0], voffA[1]); } } while (0)
#define PG8_LDA(dst, b, h) do { _Pragma("unroll") for (int m = 0; m < 4; ++m) _Pragma("unroll") for (int k = 0; k < 2; ++k) dst[m][k] = *(const LAS bf16x8*)(lds + PG8_SA(b, h) + aoff + m * 2048 + k * 1024); } while (0)
#define PG8_LDB(dst, b, h) do { _Pragma("unroll") for (int n = 0; n < 2; ++n) _Pragma("unroll") for (int k = 0; k < 2; ++k) dst[n][k] = *(const LAS bf16x8*)(lds + PG8_SB(b, h) + boff + n * 2048 + k * 1024); } while (0)
#define PG8_MMA(ai, bj, At, Bt) do { __builtin_amdgcn_s_setprio(1); \
        if constexpr (FP8) { _Pragma("unroll") for (int m = 0; m < 4; ++m) _Pragma("unroll") for (int n = 0; n < 2; ++n) \
            mfma_fp8(acc[ai][bj][m][n], cat8(Bt[n][0], Bt[n][1]), cat8(At[m][0], At[m][1]), f8one); } \
        else { _Pragma("unroll") for (int m = 0; m < 4; ++m) _Pragma("unroll") for (int n = 0; n < 2; ++n) _Pragma("unroll") for (int k = 0; k < 2; ++k) \
            acc[ai][bj][m][n] = __builtin_amdgcn_mfma_f32_16x16x32_bf16(Bt[n][k], At[m][k], acc[ai][bj][m][n], 0, 0, 0); } \
        __builtin_amdgcn_s_setprio(0); } while (0)
#define PG8_WAIT_V(n) asm volatile("s_waitcnt vmcnt(" #n ")" ::: "memory")
#define PG8_WAIT_L(n) asm volatile("s_waitcnt lgkmcnt(" #n ")" ::: "memory")
#define PG8_BAR __builtin_amdgcn_s_barrier()
#define PG8_SCHED __builtin_amdgcn_sched_barrier(0)
    Unit cur, nxt; int ui = 0;
    if (!S.next(0, cur)) return;
    f32x4 acc[2][2][4][2];
#pragma unroll
    for (int a = 0; a < 2; ++a)
#pragma unroll
        for (int b = 0; b < 2; ++b)
#pragma unroll
            for (int m = 0; m < 4; ++m)
#pragma unroll
                for (int n = 0; n < 2; ++n) acc[a][b][m][n] = (f32x4){0.f, 0.f, 0.f, 0.f};
    bf16x8 At[4][2], B0[2][2], B1[2][2];
    int f8one = 0x7f7f7f7f; asm volatile("" : "+v"(f8one));
    const char* cA = S.a_ptr(cur); const char* cB = S.b_ptr(cur);
    int co = 0, no = 0; if constexpr (KROT) co = S.koff(cur, nt);
    const char* pA = cA + (size_t)co * kstep; const char* pB = cB + (size_t)co * kstep;
    if constexpr (EPF) E.prefetch(lds + LDS_EPI_OFF, cur, wid, lane);
    unsigned ca00 = 0, ca01 = 0, ca10 = 0, ca11 = 0;
    if constexpr (GATHER) { const int* rw = S.rows(cur); const int pv = cur.pv;
        ca00 = (unsigned)(Rr[0] < pv ? rw[Rr[0]] : 0) * lda2 + Cc[0] * 2; ca01 = (unsigned)(Rr[1] < pv ? rw[Rr[1]] : 0) * lda2 + Cc[1] * 2; ca10 = (unsigned)(HALF + Rr[0] < pv ? rw[HALF + Rr[0]] : 0) * lda2 + Cc[0] * 2; ca11 = (unsigned)(HALF + Rr[1] < pv ? rw[HALF + Rr[1]] : 0) * lda2 + Cc[1] * 2; }
    if constexpr (SP2) {
        PG8_STB(PG8_SB(0, 0), pB); PG8_STB(PG8_SB(0, 1), pB + hstepB); PG8_STA(PG8_SA(0, 0), pA, 0, ca00, ca01); PG8_STA(PG8_SA(0, 1), pA, 1, ca10, ca11);
        if (wr == 1) PG8_BAR;
        PG8_WAIT_V(2); PG8_BAR;
        PG8_STB(PG8_SB(1, 0), pB + kstep); PG8_STA(PG8_SA(1, 0), pA + kstep, 0, ca00, ca01); PG8_STB(PG8_SB(1, 1), pB + hstepB + kstep);
        PG8_WAIT_V(6); PG8_BAR;
    } else {
        PG8_STB(PG8_SB(0, 0), cB); PG8_STA(PG8_SA(0, 0), cA, 0, ca00, ca01); PG8_STB(PG8_SB(0, 1), cB + hstepB); PG8_STA(PG8_SA(0, 1), cA, 1, ca10, ca11);
        if (wr == 1) PG8_BAR;
        PG8_WAIT_V(4); PG8_BAR;
        PG8_STB(PG8_SB(1, 0), cB + kstep); PG8_STA(PG8_SA(1, 0), cA + kstep, 0, ca00, ca01); PG8_STB(PG8_SB(1, 1), cB + hstepB + kstep);
        PG8_WAIT_V(6); PG8_BAR;
    }
    for (;;) {
        const bool has_next = S.next(ui + 1, nxt);
        const char* nA = has_next ? S.a_ptr(nxt) : cA; const char* nB = has_next ? S.b_ptr(nxt) : cB;
        if constexpr (KROT) no = has_next ? S.koff(nxt, nt) : co;
        size_t cskip = 0; if constexpr (CATK) cskip = S.a_skip(cur);
        if constexpr (EPF) { if (has_next) E.prefetch(lds + LDS_EPI_OFF + ((ui + 1) % 3) * LDS_EPI_BUF, nxt, wid, lane); }
        int nr00 = 0, nr01 = 0, nr10 = 0, nr11 = 0;
        int pvn = 0;
        if constexpr (GATHER) { const int* rw = has_next ? S.rows(nxt) : S.rows(cur); pvn = has_next ? nxt.pv : cur.pv; nr00 = rw[Rr[0]]; nr01 = rw[Rr[1]]; nr10 = rw[HALF + Rr[0]]; nr11 = rw[HALF + Rr[1]]; }
        unsigned na00 = ca00, na01 = ca01, na10 = ca10, na11 = ca11;
        const bool do0 = !HALFU || cur.ph != 2, do1 = !HALFU || cur.ph != 1;
        for (int t = 0; t < nt; t += 2) {
            const bool last = (t == nt - 2);
            const int kt = (KROT && t + co >= nt) ? t + co - nt : t + co, kt2 = (KROT && t + 2 + co >= nt) ? t + 2 + co - nt : t + 2 + co;
            const char* a1 = cA + (size_t)(kt + 1) * kstep + ((CATK && t >= 2) ? cskip : 0);
            const char* a2 = last ? nA + (size_t)no * kstep : cA + (size_t)kt2 * kstep + (CATK ? cskip : 0); const char* b2 = last ? nB + (size_t)no * kstep : cB + (size_t)kt2 * kstep;
            const char* a3 = a2 + kstep; const char* b3 = b2 + kstep;
            unsigned s00 = ca00, s01 = ca01, s10 = ca10, s11 = ca11;
            if constexpr (GATHER) { if (last) { na00 = (unsigned)(Rr[0] < pvn ? nr00 : 0) * lda2 + Cc[0] * 2; na01 = (unsigned)(Rr[1] < pvn ? nr01 : 0) * lda2 + Cc[1] * 2; na10 = (unsigned)(HALF + Rr[0] < pvn ? nr10 : 0) * lda2 + Cc[0] * 2; na11 = (unsigned)(HALF + Rr[1] < pvn ? nr11 : 0) * lda2 + Cc[1] * 2;
                                               s00 = na00; s01 = na01; s10 = na10; s11 = na11; } }
            if constexpr (SP2) {
            PG8_LDB(B0, 0, 0); PG8_LDB(B1, 0, 1); PG8_SCHED; PG8_LDA(At, 0, 0); PG8_STA(PG8_SA(1, 1), a1, 1, ca10, ca11);
            PG8_WAIT_V(8); PG8_WAIT_L(0); PG8_BAR; if (do0) { PG8_MMA(0, 0, At, B0); PG8_MMA(0, 1, At, B1); } PG8_BAR; PG8_SCHED;
            PG8_LDA(At, 0, 1); PG8_STB(PG8_SB(0, 0), b2); PG8_STB(PG8_SB(0, 1), b2 + hstepB); PG8_STA(PG8_SA(0, 0), a2, 0, s00, s01);
            PG8_WAIT_V(8); PG8_WAIT_L(0); PG8_BAR; if (do1) { PG8_MMA(1, 0, At, B0); PG8_MMA(1, 1, At, B1); } PG8_BAR; PG8_SCHED;
            PG8_LDB(B0, 1, 0); PG8_LDB(B1, 1, 1); PG8_SCHED; PG8_LDA(At, 1, 0); PG8_STA(PG8_SA(0, 1), a2, 1, s10, s11);
            PG8_WAIT_V(8); PG8_WAIT_L(0); PG8_BAR; if (do0) { PG8_MMA(0, 0, At, B0); PG8_MMA(0, 1, At, B1); } PG8_BAR; PG8_SCHED;
            PG8_LDA(At, 1, 1); PG8_STB(PG8_SB(1, 0), b3); PG8_STB(PG8_SB(1, 1), b3 + hstepB); PG8_STA(PG8_SA(1, 0), a3, 0, s00, s01);
            PG8_WAIT_V(8); PG8_WAIT_L(0); PG8_BAR; if (do1) { PG8_MMA(1, 0, At, B0); PG8_MMA(1, 1, At, B1); } PG8_BAR; PG8_SCHED;
            } else {
            PG8_LDB(B0, 0, 0); PG8_SCHED; PG8_LDA(At, 0, 0); PG8_STA(PG8_SA(1, 1), a1, 1, ca10, ca11);
            PG8_WAIT_L(8); PG8_BAR; PG8_WAIT_L(0); PG8_MMA(0, 0, At, B0); PG8_BAR; PG8_SCHED;
            PG8_LDB(B1, 0, 1); PG8_STB(PG8_SB(0, 0), b2);
            PG8_BAR; PG8_WAIT_L(0); PG8_MMA(0, 1, At, B1); PG8_BAR;
            PG8_LDA(At, 0, 1); PG8_STA(PG8_SA(0, 0), a2, 0, s00, s01);
            PG8_BAR; PG8_WAIT_L(0); PG8_MMA(1, 0, At, B0); PG8_BAR; PG8_SCHED;
            PG8_STB(PG8_SB(0, 1), b2 + hstepB);
            PG8_WAIT_V(6); PG8_BAR; PG8_MMA(1, 1, At, B1); PG8_BAR;
            PG8_LDB(B0, 1, 0); PG8_SCHED; PG8_LDA(At, 1, 0); PG8_STA(PG8_SA(0, 1), a2, 1, s10, s11);
            PG8_WAIT_L(8); PG8_BAR; PG8_WAIT_L(0); PG8_MMA(0, 0, At, B0); PG8_BAR; PG8_SCHED;
            PG8_LDB(B1, 1, 1); PG8_STB(PG8_SB(1, 0), b3);
            PG8_BAR; PG8_WAIT_L(0); PG8_MMA(0, 1, At, B1); PG8_BAR;
            PG8_LDA(At, 1, 1); PG8_STA(PG8_SA(1, 0), a3, 0, s00, s01);
            PG8_BAR; PG8_WAIT_L(0); PG8_MMA(1, 0, At, B0); PG8_BAR; PG8_SCHED;
            PG8_STB(PG8_SB(1, 1), b3 + hstepB);
            PG8_WAIT_V(6); PG8_BAR; PG8_MMA(1, 1, At, B1); PG8_BAR;
            }
            if constexpr (CATK) { if (t == 0) { int fr2 = fr, fq2 = fq; asm volatile("" : "+v"(fr2), "+v"(fq2)); E.mid(acc, cur, wr, wc, fr2, fq2); } }
        }
        if constexpr (ALIGN_EPI) { if (wr == 0) PG8_BAR; }
        if constexpr (FP8) {
#define PG8_T8(a, b) "+v"(acc[a][b][0][0]), "+v"(acc[a][b][0][1]), "+v"(acc[a][b][1][0]), "+v"(acc[a][b][1][1]), "+v"(acc[a][b][2][0]), "+v"(acc[a][b][2][1]), "+v"(acc[a][b][3][0]), "+v"(acc[a][b][3][1])
            asm volatile("s_nop 15\n\ts_nop 7" : PG8_T8(0, 0), PG8_T8(0, 1));
            asm volatile("" : PG8_T8(1, 0), PG8_T8(1, 1));
#undef PG8_T8
        }
        if constexpr (EPF) E(acc, cur, wr, wc, fr, fq, lds + LDS_EPI_OFF + (ui % 3) * LDS_EPI_BUF); else E(acc, cur, wr, wc, fr, fq);
        if (!has_next) break;
#pragma unroll
        for (int a = 0; a < 2; ++a)
#pragma unroll
            for (int b = 0; b < 2; ++b)
#pragma unroll
                for (int m = 0; m < 4; ++m)
#pragma unroll
                    for (int n = 0; n < 2; ++n) acc[a][b][m][n] = (f32x4){0.f, 0.f, 0.f, 0.f};
        cur = nxt; cA = nA; cB = nB; co = no; ++ui; ca00 = na00; ca01 = na01; ca10 = na10; ca11 = na11;
        if constexpr (ALIGN_EPI) { if (wr == 1) PG8_BAR; }
    }
    PG8_WAIT_V(0);
    if constexpr (!ALIGN_EPI) { if (wr == 0) PG8_BAR; }
    PG8_BAR;
#undef PG8_SA
#undef PG8_SB
#undef PG8_ST2
#undef PG8_STB
#undef PG8_STA
#undef PG8_LDA
#undef PG8_LDB
#undef PG8_MMA
#undef PG8_WAIT_V
#undef PG8_WAIT_L
#undef PG8_BAR
#undef PG8_SCHED
}
}
using pg8::Unit;
typedef f32x4 Acc[2][2][4][2];

__device__ __forceinline__ void glds4(const float* src_lane, LAS unsigned char* dst_wave) { __builtin_amdgcn_global_load_lds((const unsigned*)src_lane, (LAS unsigned*)dst_wave, 4, 0, 0); }
template <bool GATES>
struct EpiIn {
    const float* rinv; const float* b_in; bf16_t* U; bf16_t* A; bf16_t* GA; bf16_t* GB;
    __device__ __forceinline__ void prefetch(LAS unsigned char* ebuf, const Unit& u, int wid, int lane) const {
        if (wid < 4) glds4(rinv + (size_t)u.pm * 256 + wid * 64 + lane, ebuf + wid * 256);
        else { const int c = (wid - 4) * 64 + lane, pn = GATES ? u.pn + 6 : u.pn; int col = 256 * pn + c;
            if (pn >= 2 && pn < 6) col = (wid < 6) ? 512 + 128 * (pn - 2) + c : 1024 + 128 * (pn - 2) + (c - 128);
            glds4(b_in + col, ebuf + 1024 + (wid - 4) * 256); }
    }
    __device__ __forceinline__ void operator()(const Acc& acc, const Unit& u, int wr, int wc, int fr, int fq, const LAS unsigned char* ebuf) const {
        const int cc = wc * 32 + 8 * fq, pn = GATES ? u.pn + 6 : u.pn;
        const LAS float* rl_ = (const LAS float*)ebuf; const LAS float* bl = (const LAS float*)(ebuf + 1024);
        f32x4 bv[2][2];
#pragma unroll
        for (int bj = 0; bj < 2; ++bj)
#pragma unroll
            for (int n = 0; n < 2; ++n) bv[bj][n] = *(const LAS f32x4*)(bl + 128 * bj + cc + 4 * n);
#pragma unroll
        for (int ai = 0; ai < 2; ++ai)
#pragma unroll
            for (int m = 0; m < 4; ++m) {
                const int rl = ai * 128 + wr * 64 + m * 16 + fr, r = u.pm * 256 + rl; const float ri = rl_[rl];
                if (!GATES && pn < 2) {
#pragma unroll
                    for (int bj = 0; bj < 2; ++bj) { const f32x4 v0 = acc[ai][bj][m][0] * ri + bv[bj][0], v1 = acc[ai][bj][m][1] * ri + bv[bj][1];
                        *(u32x4*)(U + (size_t)r * PW + 256 * pn + 128 * bj + cc) = pack8(v0, v1); }
                } else if (!GATES) {
                    f32x4 o[2]; const float rin = ri * -1.44269504f;
#pragma unroll
                    for (int n = 0; n < 2; ++n)
#pragma unroll
                        for (int j = 0; j < 4; ++j) o[n][j] = __builtin_fmaf(acc[ai][0][m][n][j], ri, bv[0][n][j]) * __builtin_amdgcn_rcpf(1.0f + __builtin_amdgcn_exp2f(__builtin_fmaf(acc[ai][1][m][n][j], rin, bv[1][n][j] * -1.44269504f)));
                    *(u32x4*)(A + (size_t)r * CW + 128 * (pn - 2) + cc) = pack8(o[0], o[1]);
                } else {
                    bf16_t* O = (pn < 10) ? GA : GB; const int c0 = 256 * ((pn < 10) ? pn - 6 : pn - 10); const float rin = ri * (-1.44269504f / (F8_SA * F8_SW));
#pragma unroll
                    for (int bj = 0; bj < 2; ++bj) { f32x4 o[2];
#pragma unroll
                        for (int n = 0; n < 2; ++n)
#pragma unroll
                            for (int j = 0; j < 4; ++j) o[n][j] = __builtin_amdgcn_rcpf(1.0f + __builtin_amdgcn_exp2f(__builtin_fmaf(acc[ai][bj][m][n][j], rin, bv[bj][n][j] * -1.44269504f)));
                        u32x2 w; w.x = pack4_u8(o[0]); w.y = pack4_u8(o[1]); *(u32x2*)((unsigned char*)O + (size_t)r * D + c0 + 128 * bj + cc) = w; }
                }
            }
    }
};
struct EpiMix {
    const unsigned char* GA; const unsigned char* GB; const float* bias; bf16_t* MIXED;
    __device__ __forceinline__ void mid(Acc& acc, const Unit& u, int wr, int wc, int fr, int fq) const {
        const int row0 = u.pm * 256 + wr * 64 + fr, col0 = u.pn * 256 + wc * 32 + 8 * fq;
#pragma unroll
        for (int ai = 0; ai < 2; ++ai)
#pragma unroll
            for (int m = 0; m < 4; ++m) { const size_t off = (size_t)(row0 + ai * 128 + m * 16) * D + col0;
#pragma unroll
                for (int bj = 0; bj < 2; ++bj) { const u32x2 ga = *(const u32x2*)(GA + off + bj * 128), gb = *(const u32x2*)(GB + off + bj * 128);
                    const f32x4 a0 = unpack4_u8(ga.x), a1 = unpack4_u8(ga.y), b0 = unpack4_u8(gb.x), b1 = unpack4_u8(gb.y);
#pragma unroll
                    for (int j = 0; j < 4; ++j) { acc[ai][bj][m][0][j] *= a0[j] * __builtin_amdgcn_rcpf(fmaxf(b0[j], 1.0f / 255.0f)); acc[ai][bj][m][1][j] *= a1[j] * __builtin_amdgcn_rcpf(fmaxf(b1[j], 1.0f / 255.0f)); }
                    asm volatile("" ::: "memory"); } }
    }
    __device__ __forceinline__ void operator()(const Acc& acc, const Unit& u, int wr, int wc, int fr, int fq) const {
        const int row0 = u.pm * 256 + wr * 64 + fr, col0 = u.pn * 256 + wc * 32 + 8 * fq;
#pragma unroll
        for (int bj = 0; bj < 2; ++bj) {
            const f32x4 b0 = *(const f32x4*)(bias + col0 + bj * 128), b1 = *(const f32x4*)(bias + col0 + bj * 128 + 4);
#pragma unroll
            for (int ai = 0; ai < 2; ++ai)
#pragma unroll
                for (int m = 0; m < 4; ++m) { const size_t off = (size_t)(row0 + ai * 128 + m * 16) * D + col0 + bj * 128;
                    const u32x2 gw = *(const u32x2*)(GB + off); f32x4 g0 = unpack4_u8(gw.x), g1 = unpack4_u8(gw.y);
#pragma unroll
                    for (int j = 0; j < 4; ++j) { g0[j] = fmaxf(g0[j], 1.0f / 255.0f); g1[j] = fmaxf(g1[j], 1.0f / 255.0f); }
                    *(u32x4*)(MIXED + off) = pack8(g0 * (acc[ai][bj][m][0] + b0), g1 * (acc[ai][bj][m][1] + b1));
                    asm volatile("" ::: "memory"); }
        }
    }
};
struct EpiOut {
    const bf16_t* x; bf16_t* H1; bf16_t* H1B;
    __device__ __forceinline__ void operator()(const Acc& acc, const Unit& u, int wr, int wc, int fr, int fq) const {
        const int row0 = u.pm * 256 + wr * 64 + fr, col0 = u.pn * 256 + wc * 32 + 8 * fq;
#pragma unroll
        for (int ai = 0; ai < 2; ++ai)
#pragma unroll
            for (int m = 0; m < 4; ++m) { const size_t off = (size_t)(row0 + ai * 128 + m * 16) * D + col0;
#pragma unroll
                for (int bj = 0; bj < 2; ++bj) { f32x4 x0, x1; unpack8(*(const u32x4*)(x + off + bj * 128), x0, x1); const f32x4 h0 = x0 + acc[ai][bj][m][0], h1 = x1 + acc[ai][bj][m][1];
                    *(u32x4*)(H1 + off + bj * 128) = pack8(h0, h1);
                    if (MK_FP8) *(u32x2*)((unsigned char*)H1B + off + bj * 128) = pack8_fp8(h0, h1, F8_SA); } }
    }
};
struct EpiUp {
    const LAS int* tile_e; const float* rs; const float* bgu; bf16_t* ACT;
    __device__ __forceinline__ void prefetch(LAS unsigned char* ebuf, const Unit& u, int wid, int lane) const {
        const int e = u.pe;
        if (wid < 4) glds4(rs + (size_t)u.pm * 256 + wid * 64 + lane, ebuf + wid * 256);
        else { const int c = (wid - 4) * 64 + lane; glds4(bgu + (size_t)e * 2048 + (wid < 6 ? 128 * u.pn + c : 1024 + 128 * u.pn + (c - 128)), ebuf + 1024 + (wid - 4) * 256); }
    }
    __device__ __forceinline__ void operator()(const Acc& acc, const Unit& u, int wr, int wc, int fr, int fq, const LAS unsigned char* ebuf) const {
        const int row0 = u.pm * 256 + wr * 64 + fr, cc = wc * 32 + 8 * fq, j0 = 128 * u.pn + cc;
        const LAS float* rsl = (const LAS float*)ebuf; const LAS float* bl = (const LAS float*)(ebuf + 1024);
        f32x4 bg[2], bu[2];
#pragma unroll
        for (int n = 0; n < 2; ++n) { bg[n] = *(const LAS f32x4*)(bl + cc + 4 * n); bu[n] = *(const LAS f32x4*)(bl + 128 + cc + 4 * n); }
#pragma unroll
        for (int ai = 0; ai < 2; ++ai)
#pragma unroll
            for (int m = 0; m < 4; ++m) { if (u.ph == 2 - ai) continue;
                const int rl = ai * 128 + wr * 64 + m * 16 + fr, r = u.pm * 256 + rl; const float sc = rsl[rl]; f32x4 o[2];
#pragma unroll
                for (int n = 0; n < 2; ++n) {
#pragma unroll
                    for (int j = 0; j < 4; ++j) { const float gg = fminf(__builtin_fmaf(acc[ai][0][m][n][j], sc, bg[n][j]), SW_LIMIT), uu = fminf(fmaxf(__builtin_fmaf(acc[ai][1][m][n][j], sc, bu[n][j]), -SW_LIMIT), SW_LIMIT);
                        const float sg = gg * __builtin_amdgcn_rcpf(1.0f + __builtin_amdgcn_exp2f(gg * (-SW_ALPHA * 1.44269504f)));
                        o[n][j] = (MK_FP8 ? __builtin_fmaf(uu, F8_SACT, F8_SACT) : (uu + 1.0f)) * sg; } }
                if (MK_FP8) *(u32x2*)((unsigned char*)ACT + (size_t)r * DE + j0) = pack8_fp8_nc(o[0], o[1], 1.0f);     else *(u32x4*)(ACT + (size_t)r * DE + j0) = pack8(o[0], o[1]); }
        (void)row0;
    }
};
struct EpiDown {
    const LAS int* tile_e; const float* gate; const float* bdn; bf16_t* YC;
    __device__ __forceinline__ void prefetch(LAS unsigned char* ebuf, const Unit& u, int wid, int lane) const {
        const int e = u.pe;
        if (wid < 4) glds4(gate + (size_t)u.pm * 256 + wid * 64 + lane, ebuf + wid * 256);
        else glds4(bdn + (size_t)e * D + 256 * u.pn + (wid - 4) * 64 + lane, ebuf + 1024 + (wid - 4) * 256);
    }
    __device__ __forceinline__ void operator()(const Acc& acc, const Unit& u, int wr, int wc, int fr, int fq, const LAS unsigned char* ebuf) const {
        const int cl = wc * 32 + 8 * fq, col0 = u.pn * 256 + cl;
        const LAS float* gl = (const LAS float*)ebuf; const LAS float* bl = (const LAS float*)(ebuf + 1024);
        f32x4 bv[2][2];
#pragma unroll
        for (int bj = 0; bj < 2; ++bj)
#pragma unroll
            for (int n = 0; n < 2; ++n) bv[bj][n] = *(const LAS f32x4*)(bl + cl + bj * 128 + 4 * n);
        if (MK_FP8) {
            const int colw = u.pn * 256 + wc * 32 + 16 * (fq >> 1);
#pragma unroll
            for (int ai = 0; ai < 2; ++ai)
#pragma unroll
                for (int mp = 0; mp < 2; ++mp) { if (u.ph == 2 - ai) continue;
                    const int rla = ai * 128 + wr * 64 + (2 * mp) * 16 + fr, rlb = rla + 16; const float ga = gl[rla] * F8_SY, gb = gl[rlb] * F8_SY; const float dsc = 1.0f / (F8_SACT * F8_SW);
                    const int rl = (fq & 1) ? rlb : rla;
#pragma unroll
                    for (int bj = 0; bj < 2; ++bj) {
                        const u32x2 pa = pack8_fp8((acc[ai][bj][2 * mp][0] * dsc + bv[bj][0]) * ga, (acc[ai][bj][2 * mp][1] * dsc + bv[bj][1]) * ga, 1.0f);
                        const u32x2 pb = pack8_fp8((acc[ai][bj][2 * mp + 1][0] * dsc + bv[bj][0]) * gb, (acc[ai][bj][2 * mp + 1][1] * dsc + bv[bj][1]) * gb, 1.0f);
                        *(u32x4*)((unsigned char*)YC + (size_t)(u.pm * 256 + rl) * D + colw + bj * 128) = widen_pair(pa, pb, fq); } }
        } else {
#pragma unroll
        for (int ai = 0; ai < 2; ++ai)
#pragma unroll
            for (int m = 0; m < 4; ++m) { const int rl = ai * 128 + wr * 64 + m * 16 + fr, r = u.pm * 256 + rl; const float g = gl[rl];
#pragma unroll
                for (int bj = 0; bj < 2; ++bj) { const f32x4 y0 = (acc[ai][bj][m][0] + bv[bj][0]) * g, y1 = (acc[ai][bj][m][1] + bv[bj][1]) * g;
                    *(u32x4*)(YC + (size_t)r * D + col0 + bj * 128) = pack8(y0, y1); } }
        }
    }
};

#define XB_TMO      128
#define XB_XCNT(j)  (256  + 64 * (j))
#define XB_XSUB(j)  (1280 + 64 * (j))
#define XB_XGEN(j)  (2304 + 64 * (j))
#define XB_TOP      3328
#define XB_TOPGEN   3392
#define XCD_BAR_WORDS 3456
#define XB_SPIN_CAP (1u << 18)
__device__ __forceinline__ unsigned xb_ld(unsigned* p)              { return __hip_atomic_load(p, __ATOMIC_RELAXED, __HIP_MEMORY_SCOPE_AGENT); }
__device__ __forceinline__ unsigned xb_add(unsigned* p, unsigned v) { return __hip_atomic_fetch_add(p, v, __ATOMIC_RELAXED, __HIP_MEMORY_SCOPE_AGENT); }
__device__ __forceinline__ unsigned xb_xcc_id() { return (unsigned)__builtin_amdgcn_s_getreg((3 << 11) | 20) & 0xFu; }
#define XB_SPIN(cond, bar) do { unsigned _sp = 0; while (cond) { __builtin_amdgcn_s_sleep(1); \
    if ((++_sp & 255u) == 0u) { if (xb_ld(&(bar)[XB_TMO])) break; if (_sp > XB_SPIN_CAP) { atomicAdd(&(bar)[XB_TMO], 1u); break; } } } } while (0)
struct XcdBarrier { unsigned* bar; unsigned x; volatile LAS unsigned* st; };
__device__ __forceinline__ XcdBarrier xcd_barrier_post(unsigned* bar, volatile LAS unsigned* st) {
    XcdBarrier b; b.bar = bar; b.x = xb_xcc_id(); b.st = st;
    if (threadIdx.x == 0) (void)xb_add(&bar[XB_XCNT(b.x)], 1u);
    return b;
}
__device__ __forceinline__ void xcd_barrier_complete(unsigned* bar, unsigned x, unsigned& nloc, unsigned& nx) {
    const unsigned G = gridDim.x * gridDim.y * gridDim.z;
    unsigned sum, cnt, mine, sp = 0u;
    for (;;) {
        sum = 0u; cnt = 0u; mine = 0u;
#pragma unroll
        for (unsigned j = 0; j < 16; ++j) { const unsigned c = xb_ld(&bar[XB_XCNT(j)]); sum += c; cnt += (c > 0u) ? 1u : 0u; mine = (j == x) ? c : mine; }
        if (sum == G) break;
        __builtin_amdgcn_s_sleep(1);
        if ((++sp & 255u) == 0u) { if (xb_ld(&bar[XB_TMO])) break; if (sp > XB_SPIN_CAP) { atomicAdd(&bar[XB_TMO], 1u); break; } }
    }
    nloc = mine > 0u ? mine : 1u; nx = cnt > 0u ? cnt : 1u;
}
__device__ __forceinline__ void xcd_barrier(const XcdBarrier& b) {
    asm volatile("s_waitcnt vmcnt(0)" ::: "memory");
    __syncthreads();
    if (threadIdx.x == 0) {
        unsigned* bar = b.bar;
        __builtin_amdgcn_s_waitcnt(0);
        unsigned nloc = b.st[0], nx = b.st[1];
        if (nloc == 0u) { xcd_barrier_complete(bar, b.x, nloc, nx); b.st[0] = nloc; b.st[1] = nx; }
        const unsigned old = xb_add(&bar[XB_XSUB(b.x)], 1u);
        const unsigned gen = old / nloc;
        if (old + 1u == (gen + 1u) * nloc) {
            __builtin_amdgcn_fence(__ATOMIC_RELEASE, "agent");
            asm volatile("s_waitcnt vmcnt(0)" ::: "memory");
            const unsigned og = xb_add(&bar[XB_TOP], 1u);
            const unsigned tg = og / nx;
            if (og + 1u == (tg + 1u) * nx) xb_add(&bar[XB_TOPGEN], 1u);
            else XB_SPIN(xb_ld(&bar[XB_TOPGEN]) == tg, bar);
            __builtin_amdgcn_fence(__ATOMIC_ACQUIRE, "agent");
            xb_add(&bar[XB_XGEN(b.x)], 1u);
            asm volatile("s_waitcnt vmcnt(0)" ::: "memory");
        } else {
            XB_SPIN(xb_ld(&bar[XB_XGEN(b.x)]) == gen, bar);
            __builtin_amdgcn_fence(__ATOMIC_ACQUIRE, "agent");
            asm volatile("s_waitcnt vmcnt(0)" ::: "memory");
        }
    }
    __syncthreads();
}

__device__ __forceinline__ void xcd_arrive2(unsigned* barA, unsigned* barB, const XcdBarrier& b) {
    asm volatile("s_waitcnt vmcnt(0)" ::: "memory");
    __syncthreads();
    if (threadIdx.x == 0) {
        __builtin_amdgcn_s_waitcnt(0);
        unsigned nloc = b.st[0], nx = b.st[1];
        if (nloc == 0u) { xcd_barrier_complete(barA, b.x, nloc, nx); b.st[0] = nloc; b.st[1] = nx; }
        const unsigned old = xb_add(&barB[XB_XSUB(b.x)], 1u);
        const unsigned gen = old / nloc;
        if (old + 1u == (gen + 1u) * nloc) {
            __builtin_amdgcn_fence(__ATOMIC_RELEASE, "agent");
            asm volatile("s_waitcnt vmcnt(0)" ::: "memory");
            const unsigned og = xb_add(&barB[XB_TOP], 1u);
            const unsigned tg = og / nx;
            if (og + 1u == (tg + 1u) * nx) xb_add(&barB[XB_TOPGEN], 1u);
        }
    }
}
__device__ __forceinline__ void xcd_wait2(unsigned* barA, unsigned* barB, unsigned k) {
    asm volatile("s_waitcnt vmcnt(0)" ::: "memory");
    __syncthreads();
    if (threadIdx.x == 0) {
        XB_SPIN(xb_ld(&barB[XB_TOPGEN]) <= k, barA);
        __builtin_amdgcn_fence(__ATOMIC_ACQUIRE, "agent");
        asm volatile("s_waitcnt vmcnt(0)" ::: "memory");
    }
    __syncthreads();
}

struct Args {
    const float* in[22]; float* out; unsigned char* ws; int ph_lo, ph_hi, bar_region, pad;
};
struct Frame {
    LAS unsigned char* lds; int tid, lane, wave, vcu, G;
    const float *x, *meta, *g1, *w_in, *b_in, *w_pool, *pool_scale, *w_dw, *b_dw, *ln_g, *ln_b, *w_pw2, *b_pw2, *w_out, *g2, *router_w, *router_b, *w_gu, *b_gu, *w_dn, *b_dn, *gf;
    float* out; unsigned char* ws;
};

__device__ __forceinline__ int rowmap(int mode, int n) {
    if (mode == 1) { if (n >= 512 && n < 1024) { const int c = n - 512; return 512 + (c >> 7) * 256 + (c & 127); } if (n >= 1024 && n < 1536) { const int c = n - 1024; return 512 + (c >> 7) * 256 + 128 + (c & 127); } return n; }
    if (mode == 2) { if (n < 1024) return (n >> 7) * 256 + (n & 127); const int c = n - 1024; return (c >> 7) * 256 + 128 + (c & 127); }
    return n;
}
__device__ __forceinline__ void p0_transpose_item(const float* W, int K, int N, const float* sk, const float* sn, bf16_t* WT, int mode, LAS float* scr, int item, int lane, int ldo = 0, int ldw = 0) {
    if (ldo == 0) ldo = K;
    if (ldw == 0) ldw = N;
    const int nblk = N / 64, kb = item / nblk, nb = item % nblk, k0 = 64 * kb, n0 = 64 * nb;
    const int r4 = lane >> 4, c16 = lane & 15;
    f32x4 v[16];
#pragma unroll
    for (int i = 0; i < 16; ++i) v[i] = __builtin_nontemporal_load((const f32x4*)(W + (size_t)(k0 + 4 * i + r4) * ldw + n0 + 4 * c16));
    f32x4 snv = (f32x4){1.f, 1.f, 1.f, 1.f}; if (sn) snv = *(const f32x4*)(sn + n0 + 4 * c16);
#pragma unroll
    for (int i = 0; i < 16; ++i) { const int kk = 4 * i + r4; const float skv = sk ? sk[k0 + kk] : 1.0f; const f32x4 o = v[i] * snv * skv; LAS float* d = scr + kk * 65 + 4 * c16; d[0] = o[0]; d[1] = o[1]; d[2] = o[2]; d[3] = o[3]; }
    LDS_WAIT(); asm volatile("" ::: "memory");
    const int c = lane & 7;
#pragma unroll
    for (int j = 0; j < 8; ++j) { const int n = (lane >> 3) + 8 * j; const LAS float* s = scr + (8 * c) * 65 + n;
        u32x4 o; o.x = cvt_pk_bf16(s[0 * 65], s[1 * 65]); o.y = cvt_pk_bf16(s[2 * 65], s[3 * 65]); o.z = cvt_pk_bf16(s[4 * 65], s[5 * 65]); o.w = cvt_pk_bf16(s[6 * 65], s[7 * 65]);
        *(u32x4*)(WT + (size_t)rowmap(mode, n0 + n) * ldo + k0 + 8 * c) = o; }
    LDS_WAIT(); asm volatile("" ::: "memory");
}

struct T8Item { const float* W; const float* sk; unsigned char* WT; int K, N, mode, item, ldw; };
__device__ __forceinline__ void t8_load(const T8Item& t, f32x4 (&v)[16], int lane) {
    const int nblk = t.N / 32, kb = t.item / nblk, nb = t.item % nblk, k0 = 128 * kb, n0 = 32 * nb, r8 = lane >> 3, c8 = lane & 7;
#pragma unroll
    for (int i = 0; i < 16; ++i) v[i] = __builtin_nontemporal_load((const f32x4*)(t.W + (size_t)(k0 + 8 * i + r8) * t.ldw + n0 + 4 * c8));
}
__device__ __forceinline__ void t8_finish(const T8Item& t, const f32x4 (&v)[16], float scale, LAS float* scr, int lane) {
    const int nblk = t.N / 32, kb = t.item / nblk, nb = t.item % nblk, k0 = 128 * kb, n0 = 32 * nb, r8 = lane >> 3, c8 = lane & 7;
#pragma unroll
    for (int i = 0; i < 16; ++i) { const int kk = 8 * i + r8; const float skv = (t.sk ? t.sk[k0 + kk] : 1.0f) * scale; const f32x4 o = v[i] * skv; LAS float* d = scr + kk * 33 + 4 * (kk >> 4) + 4 * c8; d[0] = o[0]; d[1] = o[1]; d[2] = o[2]; d[3] = o[3]; }
    LDS_WAIT(); asm volatile("" ::: "memory");
    const int c = lane & 7;
#pragma unroll
    for (int j = 0; j < 4; ++j) { const int n = (lane >> 3) + 8 * j; const LAS float* s = scr + (16 * c) * 33 + 4 * c + n;
        u32x4 o; o.x = pack4_fp8(s[0 * 33], s[1 * 33], s[2 * 33], s[3 * 33]); o.y = pack4_fp8(s[4 * 33], s[5 * 33], s[6 * 33], s[7 * 33]);
        o.z = pack4_fp8(s[8 * 33], s[9 * 33], s[10 * 33], s[11 * 33]); o.w = pack4_fp8(s[12 * 33], s[13 * 33], s[14 * 33], s[15 * 33]);
        __builtin_nontemporal_store(o, (u32x4*)(t.WT + (size_t)rowmap(t.mode, n0 + n) * t.K + k0 + 16 * c)); }
    LDS_WAIT(); asm volatile("" ::: "memory");
}
__device__ __forceinline__ void p0_transpose_item8(const float* W, int K, int N, const float* sk, float scale, unsigned char* WT, int mode, LAS float* scr, int item, int lane, int ldw = 0) {
    const T8Item t{W, sk, WT, K, N, mode, item, ldw ? ldw : N}; f32x4 v[16]; t8_load(t, v, lane); t8_finish(t, v, scale, scr, lane);
}

constexpr int META_KS = 32;
__device__ __forceinline__ void p0_prologue(Frame& F) {
    LAS float* scr = (LAS float*)(F.lds + F.wave * 17408);
    const int gw = F.vcu * NWAVES + F.wave, NGW = F.G * NWAVES, lane = F.lane;
    unsigned char* ws = F.ws;
    bf16_t* W1T = (bf16_t*)(ws + WS_W1T); bf16_t* WPT = (bf16_t*)(ws + WS_WPT); bf16_t* PW2T = (bf16_t*)(ws + WS_PW2T); bf16_t* OUTT = (bf16_t*)(ws + WS_OUTT);
    bf16_t* GUT = (bf16_t*)(ws + WS_GUT); bf16_t* DNT = (bf16_t*)(ws + WS_DNT);
    constexpr int I_W1 = (D / 64) * (1536 / 64), I_W1G = (D / 128) * (2048 / 32), I_P = 4 * (128 / 64) * (256 / 64), I_PW2 = (CW / 64) * (D / 64), I_OUT = (D / 64) * (D / 64);
    constexpr int I_GU1 = MK_FP8 ? (D / 128) * (2 * DE / 32) : (D / 64) * (2 * DE / 64), I_DN1 = MK_FP8 ? (DE / 128) * (D / 32) : (DE / 64) * (D / 64), I_GU = NE * I_GU1, I_DN = NE * I_DN1;
    constexpr int I_WR = 16, I_META = 24 * META_KS + 1;
    constexpr int NITEMS_A = I_WR + I_META + I_W1 + I_W1G + I_P + I_PW2 + I_OUT, NITEMS = NITEMS_A + I_GU + I_DN;
    for (int it = gw; it < NITEMS_A; it += NGW) {
        int r = it;
        if (r < I_WR) {
            bf16_t* wrt = (bf16_t*)(ws + WS_MISC + M_WRT); const int k = 64 * r + lane; const float g = F.g2[k];
            for (int e = 0; e < NE; ++e) { const float v = F.router_w[(size_t)k * NE + e] * g; const unsigned hi = cvt_pk_bf16(v, 0.f) & 0xffffu; const float rem = v - __uint_as_float(hi << 16);
                wrt[(size_t)e * D + k] = (bf16_t)hi; wrt[(size_t)(NE + e) * D + k] = (bf16_t)(cvt_pk_bf16(rem, 0.f) & 0xffffu); }
            continue;
        }
        r -= I_WR;
        if (r < I_META) {
            if (r == 24 * META_KS) {
                for (int i = 0; i < NMETA; ++i) { float s = 0.f;
#pragma unroll
                    for (int j = 0; j < 4; ++j) { const f32x4 v = *(const f32x4*)(F.meta + (size_t)i * D + 4 * lane + 256 * j); s += (v[0] * v[0] + v[1] * v[1]) + (v[2] * v[2] + v[3] * v[3]); }
                    s = wave_sum(s); if (lane == 0) ((float*)(ws + WS_MISC + M_METAR))[i] = 1.0f / sqrtf(s * (1.0f / D) + RMS_EPS); }
            } else {
                const int cc = r / META_KS, ks = r % META_KS, n = cc * 64 + lane, kb = ks * (D / META_KS); float a[NMETA]; float wv[D / META_KS];
#pragma unroll
                for (int k = 0; k < D / META_KS; ++k) wv[k] = F.w_in[(size_t)(kb + k) * NCOL1 + n];
#pragma unroll
                for (int i = 0; i < NMETA; ++i) a[i] = 0.f;
#pragma unroll
                for (int k = 0; k < D / META_KS; ++k) { const float w = wv[k] * F.g1[kb + k];
#pragma unroll
                    for (int i = 0; i < NMETA; ++i) a[i] += F.meta[(size_t)i * D + kb + k] * w; }
                float* mp = (float*)(ws + WS_METAP);
#pragma unroll
                for (int i = 0; i < NMETA; ++i) mp[((size_t)ks * NMETA + i) * 1536 + n] = a[i];
            }
            continue;
        }
        r -= I_META;
        if (r < I_W1) { p0_transpose_item(F.w_in, D, 1536, F.g1, nullptr, W1T, 1, scr, r, lane, 0, NCOL1); continue; } r -= I_W1;
        if (r < I_W1G) { p0_transpose_item8(F.w_in + 1536, D, 2048, F.g1, F8_SW, ws + WS_W1G8, 0, scr, r, lane, NCOL1); continue; } r -= I_W1G;
        if (r < I_P) { const int g = r / 8; p0_transpose_item(F.w_pool + (size_t)g * 128 * 256, 128, 256, nullptr, F.pool_scale + g * 256, WPT + (size_t)g * 256 * 640, 0, scr, r % 8, lane, 640); continue; } r -= I_P;
        if (r < I_PW2) { p0_transpose_item(F.w_pw2, CW, D, nullptr, nullptr, WPT + 128, 0, scr, r, lane, 640); continue; } r -= I_PW2;
        if (r < I_OUT) { p0_transpose_item(F.w_out, D, D, nullptr, nullptr, OUTT, 0, scr, r, lane); continue; }
    }
    bf16_t* XB = (bf16_t*)(ws + WS_XB); float* rinv1 = (float*)(ws + WS_MISC + M_RINV1);
    for (int m = 4 * gw; m < NTOK; m += 4 * NGW) {
        f32x4 v[4][4];
#pragma unroll
        for (int q = 0; q < 4; ++q)
#pragma unroll
            for (int j = 0; j < 4; ++j) v[q][j] = __builtin_nontemporal_load((const f32x4*)(F.x + (size_t)(m + q) * D) + lane + 64 * j);
#pragma unroll
        for (int q = 0; q < 4; ++q) { float s = 0.f;
#pragma unroll
            for (int j = 0; j < 4; ++j) s += (v[q][j][0] * v[q][j][0] + v[q][j][1] * v[q][j][1]) + (v[q][j][2] * v[q][j][2] + v[q][j][3] * v[q][j][3]);
            s = wave_sum(s);
            u32x2* o8 = (u32x2*)(XB + (size_t)(m + q) * D) + lane; unsigned* q8 = (unsigned*)(ws + WS_XQ8 + (size_t)(m + q) * D) + lane;
#pragma unroll
            for (int j = 0; j < 4; ++j) { u32x2 w; w.x = cvt_pk_bf16(v[q][j][0], v[q][j][1]); w.y = cvt_pk_bf16(v[q][j][2], v[q][j][3]); o8[64 * j] = w;
                q8[64 * j] = pack4_fp8(v[q][j][0] * F8_SA, v[q][j][1] * F8_SA, v[q][j][2] * F8_SA, v[q][j][3] * F8_SA); }
            if (lane == 0) rinv1[m + q] = 1.0f / sqrtf(s * (1.0f / D) + RMS_EPS); }
    }
}

constexpr int P0B_NJ = 12;
__device__ __forceinline__ void p0b_expert_weights(LAS unsigned char* lds, int vcu, int G, int wave, int lane, int j0, int j1) {
    const char* kp = (const char*)__builtin_amdgcn_kernarg_segment_ptr(); asm volatile("" : "+s"(kp));
    const float* const* inp = (const float* const*)kp;
    const float* g2 = inp[14]; const float* w_gu = inp[17]; const float* w_dn = inp[19]; unsigned char* ws = *(unsigned char* const*)(kp + 23 * 8);
    LAS float* scr = (LAS float*)(lds + wave * 17408);
    const int gw = vcu * NWAVES + wave, NGW = G * NWAVES;
    bf16_t* GUT = (bf16_t*)(ws + WS_GUT); bf16_t* DNT = (bf16_t*)(ws + WS_DNT);
    constexpr int I_GU1 = MK_FP8 ? (D / 128) * (2 * DE / 32) : (D / 64) * (2 * DE / 64), I_DN1 = MK_FP8 ? (DE / 128) * (D / 32) : (DE / 64) * (D / 64), I_GU = NE * I_GU1, I_DN = NE * I_DN1;
    if (MK_FP8) {
        auto mk = [&](int r) { T8Item t; if (r < I_GU) { const int e = r / I_GU1; t = T8Item{w_gu + (size_t)e * D * 2 * DE, g2, (unsigned char*)GUT + (size_t)e * 2 * DE * D, D, 2 * DE, 2, r % I_GU1, 2 * DE}; }
                               else { const int q = r - I_GU, e = q / I_DN1; t = T8Item{w_dn + (size_t)e * DE * D, nullptr, (unsigned char*)DNT + (size_t)e * D * DE, DE, D, 0, q % I_DN1, D}; } return t; };
        constexpr int NI = I_GU + I_DN;
        const int rend = (NGW * P0B_NJ >= NI) ? gw + j1 * NGW : NI;
        f32x4 va[16], vb[16]; int r = gw + j0 * NGW; T8Item ta, tb;
        auto ok = [&](int q) { return q < NI && q < rend; };
        if (ok(r)) { ta = mk(r); t8_load(ta, va, lane); }
        while (ok(r)) {
            int r2 = r + NGW; if (ok(r2)) { tb = mk(r2); t8_load(tb, vb, lane); }
            t8_finish(ta, va, F8_SW, scr, lane);
            r = r2; if (!ok(r)) break;
            r2 = r + NGW; if (ok(r2)) { ta = mk(r2); t8_load(ta, va, lane); }
            t8_finish(tb, vb, F8_SW, scr, lane);
            r = r2;
        }
    } else {
        for (int r = gw; j0 == 0 && r < I_GU + I_DN; r += NGW) {
            if (r < I_GU) { const int e = r / I_GU1; p0_transpose_item(w_gu + (size_t)e * D * 2 * DE, D, 2 * DE, g2, nullptr, GUT + (size_t)e * 2 * DE * D, 2, scr, r % I_GU1, lane); }
            else { const int q = r - I_GU, e = q / I_DN1; p0_transpose_item(w_dn + (size_t)e * DE * D, DE, D, nullptr, nullptr, DNT + (size_t)e * D * DE, 0, scr, q % I_DN1, lane); }
        }
    }
}

__device__ __forceinline__ void p1_meta_finish(Frame& F) {
    const int per = (NMETA * 512 + F.G - 1) / F.G;
    const int o = F.vcu * per + F.tid; if (F.tid >= per || o >= NMETA * 512) return;
    const int i = o >> 9, c = o & 511; unsigned char* ws = F.ws;
    const float* mp = (const float*)(ws + WS_METAP); const float ri = ((const float*)(ws + WS_MISC + M_METAR))[i];
    float su = 0.f, sv = 0.f, sg = 0.f;
#pragma unroll
    for (int ks = 0; ks < META_KS; ++ks) { const float* p = mp + ((size_t)ks * NMETA + i) * 1536; su += p[c]; sv += p[512 + c]; sg += p[1024 + c]; }
    const float uu = su * ri + F.b_in[c], vv = sv * ri + F.b_in[512 + c], gg = sg * ri + F.b_in[1024 + c];
    ((bf16_t*)(ws + WS_MISC + M_UMETA))[o] = (bf16_t)(cvt_pk_bf16(uu, 0.f) & 0xffffu);
    ((bf16_t*)(ws + WS_MISC + M_AMETA))[o] = (bf16_t)(cvt_pk_bf16(vv * sigmoidf_(gg), 0.f) & 0xffffu);
}

__device__ __forceinline__ void p2_mixer_pre(Frame& F) {
    LAS bf16_t* wl = (LAS bf16_t*)(F.lds);
    LAS bf16_t* at = (LAS bf16_t*)(F.lds + 31744);
    LAS bf16_t* ut = (LAS bf16_t*)(F.lds + 31744 + 63488);
    unsigned char* ws = F.ws; const int tid = F.tid, lane = F.lane, w = F.wave;
    const bf16_t* Ag = (const bf16_t*)(ws + WS_A); const bf16_t* Ug = (const bf16_t*)(ws + WS_U);
    const bf16_t* am = (const bf16_t*)(ws + WS_MISC + M_AMETA); const bf16_t* um = (const bf16_t*)(ws + WS_MISC + M_UMETA);
    bf16_t* DP = (bf16_t*)(ws + WS_DP);
    __syncthreads();
    for (int idx = tid; idx < CK * 64; idx += NTHREADS) { const f32x4 a = *(const f32x4*)(F.w_dw + idx * 8), b = *(const f32x4*)(F.w_dw + idx * 8 + 4); *(LAS u32x4*)(wl + idx * 8) = pack8(a, b); }
    const int c0 = 8 * lane;
    f32x4 bdw[2], lg[2], lb[2];
#pragma unroll
    for (int n = 0; n < 2; ++n) { bdw[n] = *(const f32x4*)(F.b_dw + c0 + 4 * n); lg[n] = *(const f32x4*)(F.ln_g + c0 + 4 * n); lb[n] = *(const f32x4*)(F.ln_b + c0 + 4 * n); }
    const int win = 2 << (lane >> 4); const float winv = 1.0f / (float)win;
    constexpr int NT = NTOK / 32, NA = 62 * 64, NU = 47 * 64;
    u32x4 ra[8], ru[6];
#define P2_LOAD(tile_) do { const int b_ = (tile_) >> 7, t0_ = ((tile_) & 127) << 5; \
        _Pragma("unroll") for (int q = 0; q < 8; ++q) { const int idx = tid + q * NTHREADS; ra[q] = (u32x4){0u, 0u, 0u, 0u}; \
            if (idx < NA) { const int row = idx >> 6, ch = (idx & 63) * 8, tr = t0_ - 30 + row; \
                if (tr >= 0) ra[q] = *(const u32x4*)(Ag + ((size_t)b_ * SEQ + tr) * CW + ch); else if (tr >= -NMETA) ra[q] = *(const u32x4*)(am + (NMETA + tr) * CW + ch); } } \
        _Pragma("unroll") for (int q = 0; q < 6; ++q) { const int idx = tid + q * NTHREADS; ru[q] = (u32x4){0u, 0u, 0u, 0u}; \
            if (idx < NU) { const int row = idx >> 6, ch = (idx & 63) * 8, tr = t0_ - 15 + row; \
                if (tr >= 0) ru[q] = *(const u32x4*)(Ug + ((size_t)b_ * SEQ + tr) * PW + ch); else ru[q] = *(const u32x4*)(um + (NMETA + tr) * PW + ch); } } } while (0)
    int tile = F.vcu;
    if (tile < NT) P2_LOAD(tile);
    for (; tile < NT; tile += F.G) {
        const int b = tile >> 7, t0 = (tile & 127) << 5;
        __syncthreads();
#pragma unroll
        for (int q = 0; q < 8; ++q) { const int idx = tid + q * NTHREADS; if (idx < NA) *(LAS u32x4*)(at + idx * 8) = ra[q]; }
#pragma unroll
        for (int q = 0; q < 6; ++q) { const int idx = tid + q * NTHREADS; if (idx < NU) *(LAS u32x4*)(ut + idx * 8) = ru[q]; }
        __syncthreads();
        if (tile + F.G < NT) P2_LOAD(tile + F.G);
        const int tl0 = 4 * w;
        f32x4 acc[4][2];
#pragma unroll
        for (int i = 0; i < 4; ++i) { acc[i][0] = (f32x4){0.f, 0.f, 0.f, 0.f}; acc[i][1] = (f32x4){0.f, 0.f, 0.f, 0.f}; }
        f32x4 r0[2], r1[2], r2[2], r3[2];
        unpack8(*(const LAS u32x4*)(at + (tl0 + 0) * 512 + c0), r0[0], r0[1]); unpack8(*(const LAS u32x4*)(at + (tl0 + 1) * 512 + c0), r1[0], r1[1]); unpack8(*(const LAS u32x4*)(at + (tl0 + 2) * 512 + c0), r2[0], r2[1]);
#pragma unroll 4
        for (int j = 0; j < CK; ++j) {
            f32x4 wv[2]; unpack8(*(const LAS u32x4*)(at + (tl0 + j + 3) * 512 + c0), r3[0], r3[1]); unpack8(*(const LAS u32x4*)(wl + j * 512 + c0), wv[0], wv[1]);
#pragma unroll
            for (int n = 0; n < 2; ++n) { acc[0][n] += wv[n] * r0[n]; acc[1][n] += wv[n] * r1[n]; acc[2][n] += wv[n] * r2[n]; acc[3][n] += wv[n] * r3[n]; r0[n] = r1[n]; r1[n] = r2[n]; r2[n] = r3[n]; }
        }
        f32x4 s0 = (f32x4){0.f, 0.f, 0.f, 0.f}, s1 = s0;
        for (int k = 0; k < win; ++k) { f32x4 x0, x1; unpack8(*(const LAS u32x4*)(ut + (tl0 + 15 - k) * 512 + c0), x0, x1); s0 += x0; s1 += x1; }
#pragma unroll
        for (int i = 0; i < 4; ++i) {
            const int tl = tl0 + i; const size_t orow = (size_t)b * SEQ + t0 + tl;
            f32x4 c[2]; c[0] = acc[i][0] + bdw[0]; c[1] = acc[i][1] + bdw[1];
            float s = (c[0][0] + c[0][1]) + (c[0][2] + c[0][3]) + (c[1][0] + c[1][1]) + (c[1][2] + c[1][3]);
            const float mean = wave_sum(s) * (1.0f / CW);
            c[0] = c[0] - mean; c[1] = c[1] - mean;
            float q = (c[0][0] * c[0][0] + c[0][1] * c[0][1]) + (c[0][2] * c[0][2] + c[0][3] * c[0][3]) + (c[1][0] * c[1][0] + c[1][1] * c[1][1]) + (c[1][2] * c[1][2] + c[1][3] * c[1][3]);
            const float rstd = 1.0f / sqrtf(wave_sum(q) * (1.0f / CW) + LN_EPS);
            f32x4 o[2];
#pragma unroll
            for (int n = 0; n < 2; ++n)
#pragma unroll
                for (int j = 0; j < 4; ++j) { const float cn = c[n][j] * rstd * lg[n][j] + lb[n][j]; o[n][j] = cn * sigmoidf_(cn); }
            *(u32x4*)(DP + orow * D + 512 + c0) = pack8(o[0], o[1]);
            f32x4 u0, u1; unpack8(*(const LAS u32x4*)(ut + (tl + 15) * 512 + c0), u0, u1);
            if (i > 0) { f32x4 x0, x1; unpack8(*(const LAS u32x4*)(ut + (tl + 15 - win) * 512 + c0), x0, x1); s0 += u0 - x0; s1 += u1 - x1; }
            *(u32x4*)(DP + orow * D + c0) = pack8(s0 * winv - u0, s1 * winv - u1);
        }
    }
#undef P2_LOAD
    __syncthreads();
}

__device__ __forceinline__ void p5_router(Frame& F) {
    LAS bf16_t* ht = (LAS bf16_t*)(F.lds);
    LAS bf16_t* wt = (LAS bf16_t*)(F.lds + 34816);
    LAS float* ssl = (LAS float*)(F.lds + 34816 + 17408);
    LAS int* hist = (LAS int*)(F.lds + 34816 + 17408 + 1024);
    LAS int* bas = (LAS int*)(F.lds + 34816 + 17408 + 1024 + 128);
    unsigned char* ws = F.ws; const int tid = F.tid, lane = F.lane, w = F.wave;
    int* tokslot = (int*)(ws + WS_MISC + M_TOKSLOT); int* slottok = (int*)(ws + WS_SLOTTOK); float* slotgate = (float*)(ws + WS_SLOTGATE); float* slotrs = (float*)(ws + WS_SLOTRS);
    unsigned* ctl = (unsigned*)(ws + WS_CTL);
    const bf16_t* H1 = (const bf16_t*)(ws + WS_H1); const bf16_t* wrt = (const bf16_t*)(ws + WS_MISC + M_WRT);
    float* rinv2 = (float*)(ws + WS_MISC + M_RINV2); int* topi = (int*)(ws + WS_MISC + M_TOPI); float* gate = (float*)(ws + WS_MISC + M_GATE); int* cnt = (int*)(ws + WS_MISC + M_CNT);
    const int rg = w & 3, kh = w >> 2, i = lane & 31, p = lane >> 5;
    for (int tile = F.vcu; tile < NTOK / 128; tile += F.G) {
        const int row0 = tile * 128;
        f32x16 acc;
#pragma unroll
        for (int r = 0; r < 16; ++r) acc[r] = 0.f;
        float ss = 0.f;
        u32x4 rh[4], rw[2];
#define P5_LOAD(kc_) do { _Pragma("unroll") for (int it = 0; it < 4; ++it) { const int idx = tid + it * NTHREADS, row = idx >> 4, c8 = idx & 15; rh[it] = *(const u32x4*)(H1 + (size_t)(row0 + row) * D + (kc_) * 128 + c8 * 8); } \
        _Pragma("unroll") for (int it = 0; it < 2; ++it) { const int idx = tid + it * NTHREADS, er = idx >> 4, c8 = idx & 15; rw[it] = *(const u32x4*)(wrt + (size_t)er * D + (kc_) * 128 + c8 * 8); } } while (0)
        P5_LOAD(0);
        for (int kc = 0; kc < 8; ++kc) {
            __syncthreads();
#pragma unroll
            for (int it = 0; it < 4; ++it) { const int idx = tid + it * NTHREADS, row = idx >> 4, c8 = idx & 15; *(LAS u32x4*)(ht + row * 136 + c8 * 8) = rh[it]; }
#pragma unroll
            for (int it = 0; it < 2; ++it) { const int idx = tid + it * NTHREADS, er = idx >> 4, c8 = idx & 15; *(LAS u32x4*)(wt + er * 136 + c8 * 8) = rw[it]; }
            __syncthreads();
            if (kc < 7) P5_LOAD(kc + 1);
#pragma unroll
            for (int s4 = 0; s4 < 4; ++s4) { const int ko = 64 * kh + 16 * s4 + 8 * p;
                const u32x4 av = *(const LAS u32x4*)(ht + (32 * rg + i) * 136 + ko);
                const bf16x8 a = __builtin_bit_cast(bf16x8, av), bh = *(const LAS bf16x8*)(wt + i * 136 + ko), bl = *(const LAS bf16x8*)(wt + (NE + i) * 136 + ko);
                f32x4 h0, h1; unpack8(av, h0, h1); ss += (h0[0] * h0[0] + h0[1] * h0[1]) + (h0[2] * h0[2] + h0[3] * h0[3]) + (h1[0] * h1[0] + h1[1] * h1[1]) + (h1[2] * h1[2] + h1[3] * h1[3]);
                acc = __builtin_amdgcn_mfma_f32_32x32x16_bf16(a, bh, acc, 0, 0, 0);
                acc = __builtin_amdgcn_mfma_f32_32x32x16_bf16(a, bl, acc, 0, 0, 0); }
        }
#undef P5_LOAD
        __syncthreads();
        LAS float* lgl = (LAS float*)(F.lds);
#pragma unroll
        for (int r = 0; r < 16; ++r) { const int row = 32 * rg + (r & 3) + 8 * (r >> 2) + 4 * p; lgl[(kh * 128 + row) * 33 + i] = acc[r]; }
        ss += __shfl_xor(ss, 32);
        if (p == 0) ssl[kh * 128 + 32 * rg + i] = ss;
        if (tid < 32) hist[tid] = 0;
        __syncthreads();
        i32x4 oi = {0, 0, 0, 0}; f32x4 og = {0.f, 0.f, 0.f, 0.f}; float ri = 0.f;
        if (tid < 128) {
            const int row = tid, t = row0 + row;
            ri = 1.0f / sqrtf((ssl[row] + ssl[128 + row]) * (1.0f / D) + RMS_EPS);
            float v[NE];
#pragma unroll
            for (int e = 0; e < NE; ++e) v[e] = (lgl[row * 33 + e] + lgl[(128 + row) * 33 + e]) * ri + F.router_b[e];
            float tv[TOPK]; int ti[TOPK];
#pragma unroll
            for (int k = 0; k < TOPK; ++k) { float best = -3.0e38f; int bi = 0;
#pragma unroll
                for (int e = 0; e < NE; ++e) { if (v[e] > best) { best = v[e]; bi = e; } }
                tv[k] = best; ti[k] = bi;
#pragma unroll
                for (int e = 0; e < NE; ++e) v[e] = (e == bi) ? -3.0e38f : v[e]; }
            float ex[TOPK], den = 0.f;
#pragma unroll
            for (int k = 0; k < TOPK; ++k) { ex[k] = __expf(tv[k] - tv[0]); den += ex[k]; }
            const float rden = 1.0f / den;
#pragma unroll
            for (int k = 0; k < TOPK; ++k) { const int rank = __hip_atomic_fetch_add(&hist[ti[k]], 1, __ATOMIC_RELAXED, __HIP_MEMORY_SCOPE_WORKGROUP); oi[k] = ti[k] | (rank << 8); og[k] = ex[k] * rden; }
            *(i32x4*)(topi + (size_t)t * 4) = oi; *(f32x4*)(gate + (size_t)t * 4) = og; rinv2[t] = ri;
        }
        __syncthreads();
        if (tid < 32) { const int h = hist[tid]; cnt[tile * 32 + tid] = h;
            int b = 0; if (h) b = (int)__hip_atomic_fetch_add(ctl + CTL_CURSOR + tid * CTL_CSTRIDE, (unsigned)h, __ATOMIC_RELAXED, __HIP_MEMORY_SCOPE_AGENT);
            bas[tid] = b; if (b + h > CAP) __hip_atomic_fetch_or(ctl + CTL_OVF, 1u, __ATOMIC_RELAXED, __HIP_MEMORY_SCOPE_AGENT); }
        __syncthreads();
        if (tid < 128) { const int t = row0 + tid; i32x4 so;
#pragma unroll
            for (int k = 0; k < TOPK; ++k) { const int e = oi[k] & 255, pos = bas[e] + (oi[k] >> 8), sl = e * ESTRIDE + pos; so[k] = sl;
                if (pos < CAP) { slottok[sl] = t; slotgate[sl] = og[k]; slotrs[sl] = MK_FP8 ? ri * (1.0f / (F8_SA * F8_SW)) : ri; } }
            *(i32x4*)(tokslot + (size_t)t * 4) = so; }
    }
    __syncthreads();
}

__device__ __forceinline__ void p6_scatter(Frame& F) {
    LAS int* cl = (LAS int*)(F.lds);
    LAS int* ps = (LAS int*)(F.lds + 32768);
    LAS int* tot = (LAS int*)(F.lds + 32768 + 2048);
    LAS int* pst = (LAS int*)(F.lds + 32768 + 2048 + 128);
    LAS int* bas = (LAS int*)(F.lds + 32768 + 2048 + 128 + 256);
    unsigned char* ws = F.ws; const int tid = F.tid;
    const int* cnt = (const int*)(ws + WS_MISC + M_CNT); const int* topi = (const int*)(ws + WS_MISC + M_TOPI); const float* gate = (const float*)(ws + WS_MISC + M_GATE); const float* rinv2 = (const float*)(ws + WS_MISC + M_RINV2);
    int* tokslot = (int*)(ws + WS_MISC + M_TOKSLOT); int* slottok = (int*)(ws + WS_SLOTTOK); float* slotgate = (float*)(ws + WS_SLOTGATE); float* slotrs = (float*)(ws + WS_SLOTRS);
    int* pstart_g = (int*)(ws + WS_MISC + M_PSTART); int* tile_e = (int*)(ws + WS_MISC + M_TILEE); int* ntiles_g = (int*)(ws + WS_MISC + M_NTILES);
    __syncthreads();
    for (int i = tid; i < 256 * 32; i += NTHREADS) cl[i] = cnt[i];
    __syncthreads();
    { const int e = tid & 31, part = tid >> 5; int s = 0;
#pragma unroll
      for (int j = 0; j < 16; ++j) s += cl[(part * 16 + j) * 32 + e];
      ps[part * 32 + e] = s; }
    __syncthreads();
    if (tid < 32) { int s = 0;
#pragma unroll
        for (int j = 0; j < 16; ++j) s += ps[j * 32 + tid];
        tot[tid] = s; }
    __syncthreads();
    if (tid == 0) { int a = 0; for (int e = 0; e < NE; ++e) { pst[e] = a; a += (tot[e] + 255) & ~255; } pst[NE] = a; }
    __syncthreads();
    if (F.vcu == 0) {
        const int nt = pst[NE] >> 8;
        if (tid == 0) ntiles_g[0] = nt;
        if (tid <= NE) pstart_g[tid] = pst[tid];
        for (int mt = tid; mt < MAXTILES; mt += NTHREADS) { int e = 0;
#pragma unroll
            for (int j = 1; j < NE; ++j) e += (pst[j] <= mt * 256) ? 1 : 0;
            tile_e[mt] = e; }
    }
    if (F.vcu < NE) {
        const int e = F.vcu; for (int s = pst[e] + tot[e] + tid; s < pst[e + 1]; s += NTHREADS) { slottok[s] = 0; slotgate[s] = 0.f; slotrs[s] = 0.f; }
    }
    for (int tile = F.vcu; tile < NTOK / 128; tile += F.G) {
        __syncthreads();
        if (tid < 32) { const int part = tile >> 4; int s = 0; for (int j = 0; j < part; ++j) s += ps[j * 32 + tid]; for (int t2 = part * 16; t2 < tile; ++t2) s += cl[t2 * 32 + tid]; bas[tid] = pst[tid] + s; }
        __syncthreads();
        if (tid < 128) { const int t = tile * 128 + tid; const i32x4 ti = *(const i32x4*)(topi + (size_t)t * 4); const f32x4 g = *(const f32x4*)(gate + (size_t)t * 4); const float ri = rinv2[t]; i32x4 so;
#pragma unroll
            for (int k = 0; k < TOPK; ++k) { const int e = ti[k] & 255, rank = ti[k] >> 8, s = bas[e] + rank; so[k] = s; slottok[s] = t; slotgate[s] = g[k]; slotrs[s] = MK_FP8 ? ri * (1.0f / (F8_SA * F8_SW)) : ri; }
            *(i32x4*)(tokslot + (size_t)t * 4) = so; }
    }
    __syncthreads();
}

__device__ __forceinline__ void p9_final(Frame& F) {
    unsigned char* ws = F.ws; const int lane = F.lane; const int gw = F.vcu * NWAVES + F.wave, NGW = F.G * NWAVES;
    const bf16_t* H1 = (const bf16_t*)(ws + WS_H1); const bf16_t* YC = (const bf16_t*)(ws + WS_YC); const int* tokslot = (const int*)(ws + WS_MISC + M_TOKSLOT);
    f32x4 gf[4];
#pragma unroll
    for (int j = 0; j < 4; ++j) gf[j] = *(const f32x4*)(F.gf + 4 * lane + 256 * j);
    for (int t = gw; t < NTOK; t += NGW) {
        const i32x4 sl = *(const i32x4*)(tokslot + (size_t)t * 4);
        f32x4 h[4];
#pragma unroll
        for (int j = 0; j < 4; ++j) { const u32x2 wv = *(const u32x2*)(H1 + (size_t)t * D + 4 * lane + 256 * j); h[j] = (f32x4){bf_lo(wv.x), bf_hi(wv.x), bf_lo(wv.y), bf_hi(wv.y)}; }
#pragma unroll
        for (int k = 0; k < TOPK; ++k) {
            if (MK_FP8) { const unsigned char* yr = (const unsigned char*)YC + (size_t)sl[k] * D;
#pragma unroll
                for (int j = 0; j < 4; ++j) { const int wv = *(const int*)(yr + 4 * lane + 256 * j); const f32v2_t lo = __builtin_amdgcn_cvt_pk_f32_fp8(wv, false), hi = __builtin_amdgcn_cvt_pk_f32_fp8(wv, true);
                    h[j] += (f32x4){lo.x, lo.y, hi.x, hi.y} * (1.0f / F8_SY); }
            } else { const bf16_t* yr = YC + (size_t)sl[k] * D;
#pragma unroll
                for (int j = 0; j < 4; ++j) { const u32x2 wv = *(const u32x2*)(yr + 4 * lane + 256 * j); h[j] += (f32x4){bf_lo(wv.x), bf_hi(wv.x), bf_lo(wv.y), bf_hi(wv.y)}; } } }
        float s = 0.f;
#pragma unroll
        for (int j = 0; j < 4; ++j) s += (h[j][0] * h[j][0] + h[j][1] * h[j][1]) + (h[j][2] * h[j][2] + h[j][3] * h[j][3]);
        const float ri = 1.0f / sqrtf(wave_sum(s) * (1.0f / D) + RMS_EPS);
#pragma unroll
        for (int j = 0; j < 4; ++j) __builtin_nontemporal_store(h[j] * ri * gf[j], (f32x4*)(F.out + (size_t)t * D + 4 * lane + 256 * j));
    }
}

#ifndef MK_SP2
#define MK_SP2 true
#endif
#ifndef MK_ALIGN
#define MK_ALIGN true
#endif
constexpr int NPHASES = 10;
#ifndef MK_PHASE_MASK
#define MK_PHASE_MASK 0x3ff
#endif

__global__ void __launch_bounds__(NTHREADS, 2) fwd_kernel(Args args) {
    extern __shared__ __attribute__((aligned(16))) unsigned char lds[];
    cg::grid_group grid = cg::this_grid();
    Frame F;
    F.lds = (LAS unsigned char*)lds;
    F.tid = threadIdx.x; F.lane = F.tid & 63; F.wave = __builtin_amdgcn_readfirstlane(F.tid >> 6);
    F.G = gridDim.x; { const int bx = blockIdx.x; F.vcu = (F.G % 8 == 0) ? (bx % 8) * (F.G / 8) + bx / 8 : bx; }
    F.x = args.in[0]; F.meta = args.in[1]; F.g1 = args.in[2]; F.w_in = args.in[3]; F.b_in = args.in[4]; F.w_pool = args.in[5]; F.pool_scale = args.in[6]; F.w_dw = args.in[7]; F.b_dw = args.in[8];
    F.ln_g = args.in[9]; F.ln_b = args.in[10]; F.w_pw2 = args.in[11]; F.b_pw2 = args.in[12]; F.w_out = args.in[13]; F.g2 = args.in[14]; F.router_w = args.in[15]; F.router_b = args.in[16];
    F.w_gu = args.in[17]; F.b_gu = args.in[18]; F.w_dn = args.in[19]; F.b_dn = args.in[20]; F.gf = args.in[21];
    F.out = args.out; F.ws = args.ws;
    unsigned char* ws = args.ws;
    const int lo = args.ph_lo, hi = args.ph_hi;
#define IN(k) (((MK_PHASE_MASK >> (k)) & 1) && lo <= (k) && (k) < hi)
    volatile LAS unsigned* bst = (volatile LAS unsigned*)(F.lds + LDS_BYTES - 64);
    if (F.tid < 2) bst[F.tid] = 0u;
    __syncthreads();
    XcdBarrier bar = xcd_barrier_post((unsigned*)(ws + WS_CTL) + 4096 + args.bar_region * XCD_BAR_WORDS, bst);
#ifndef MK_CG_SEAMS
#define MK_CG_SEAMS 0x0
#endif
#ifndef MK_FILL
#define MK_FILL 2
#endif
#define SEAM(k) do { if (IN(k) && IN((k) + 1)) { if ((MK_CG_SEAMS >> (k)) & 1) grid.sync(); else xcd_barrier(bar); } } while (0)
    unsigned* const barA = (unsigned*)(ws + WS_CTL) + 4096 + args.bar_region * XCD_BAR_WORDS; unsigned* const barB = (unsigned*)(ws + WS_CTL) + 4096 + 2 * XCD_BAR_WORDS; unsigned nsplit = 0u;
#define SEAMF(k, j0, j1) do { if (IN(k) && IN((k) + 1)) { if ((j1) > (j0)) { xcd_arrive2(barA, barB, bar); p0b_expert_weights(F.lds, F.vcu, F.G, F.wave, F.lane, (j0), (j1)); xcd_wait2(barA, barB, nsplit); ++nsplit; } else xcd_barrier(bar); } } while (0)
    const int bid = (int)blockIdx.x;

    if (IN(0)) p0_prologue(F);
    SEAMF(0, 0 * MK_FILL, 1 * MK_FILL);
    if (IN(1)) {
        p1_meta_finish(F);
        const bool conv_first = ((bid >> 3) & 1) == 0;
        if (conv_first) { p0b_expert_weights(F.lds, F.vcu, F.G, F.wave, F.lane, 5 * MK_FILL, P0B_NJ); __syncthreads(); }
        {
            pg8::DenseSched S; S.init(NTOK, 1536, F.G, bid); S.A = (const char*)(ws + WS_XB); S.B = (const char*)(ws + WS_W1T); S.a_tile = (size_t)256 * D * 2; S.a_pn = 0; S.b_tile = (size_t)256 * D * 2;
            EpiIn<false> E{(const float*)(ws + WS_MISC + M_RINV1), F.b_in, (bf16_t*)(ws + WS_U), (bf16_t*)(ws + WS_A), (bf16_t*)(ws + WS_GA), (bf16_t*)(ws + WS_GB)};
            int kq = D; asm volatile("" : "+s"(kq));
            pg8::gemm_phase<EpiIn<false>, pg8::DenseSched, false, MK_ALIGN, MK_SP2, false, false, true, false, (MK_KROT & 1) != 0>(F.lds, kq, D, D, S, E);
        }
        {
            pg8::DenseSched S; S.init(NTOK, 2048, F.G, bid); S.A = (const char*)(ws + WS_XQ8); S.B = (const char*)(ws + WS_W1G8); S.a_tile = (size_t)256 * D; S.a_pn = 0; S.b_tile = (size_t)256 * D;
            EpiIn<true> E{(const float*)(ws + WS_MISC + M_RINV1), F.b_in, (bf16_t*)(ws + WS_U), (bf16_t*)(ws + WS_A), (bf16_t*)(ws + WS_GA), (bf16_t*)(ws + WS_GB)};
            int kq = D / 2; asm volatile("" : "+s"(kq));
            pg8::gemm_phase<EpiIn<true>, pg8::DenseSched, false, MK_ALIGN, MK_SP2, true, false, true, false, (MK_KROT & 2) != 0>(F.lds, kq, D / 2, D / 2, S, E);
        }
        if (!conv_first) p0b_expert_weights(F.lds, F.vcu, F.G, F.wave, F.lane, 5 * MK_FILL, P0B_NJ);
    }
    SEAMF(1, 1 * MK_FILL, 2 * MK_FILL);
    if (IN(2)) p2_mixer_pre(F);
    SEAMF(2, 2 * MK_FILL, 3 * MK_FILL);
    if (IN(3)) {
        pg8::DenseSched S; S.init(NTOK, D, F.G, bid); S.A = (const char*)(ws + WS_DP); S.B = (const char*)(ws + WS_WPT); S.a_tile = (size_t)256 * D * 2; S.a_pn = 128 * 2; S.b_tile = (size_t)256 * 640 * 2;
        EpiMix E{(const unsigned char*)(ws + WS_GA), (const unsigned char*)(ws + WS_GB), F.b_pw2, (bf16_t*)(ws + WS_MIXED)};
        int kp = 640; asm volatile("" : "+s"(kp));
        pg8::gemm_phase<EpiMix, pg8::DenseSched, false, MK_ALIGN, MK_SP2, false, true>(F.lds, kp, D, 640, S, E);
    }
    SEAMF(3, 3 * MK_FILL, 4 * MK_FILL);
    if (IN(4)) {
        pg8::DenseSched S; S.init(NTOK, D, F.G, bid); S.A = (const char*)(ws + WS_MIXED); S.B = (const char*)(ws + WS_OUTT); S.a_tile = (size_t)256 * D * 2; S.a_pn = 0; S.b_tile = (size_t)256 * D * 2;
        EpiOut E{(const bf16_t*)(ws + WS_XB), (bf16_t*)(ws + WS_H1), (bf16_t*)(ws + WS_H1B)};
        pg8::gemm_phase<EpiOut, pg8::DenseSched, false, MK_ALIGN, MK_SP2, false, false, false, false, (MK_KROT & 8) != 0>(F.lds, D, D, D, S, E);
    }
    SEAMF(4, 4 * MK_FILL, 5 * MK_FILL);
    if (IN(5)) p5_router(F);
    SEAM(5);
    const bool ovf = MK_FORCE_OVF || (__builtin_amdgcn_readfirstlane(((const unsigned*)(ws + WS_CTL))[CTL_OVF]) != 0u);
    if (IN(6) && ovf) { p6_scatter(F); if (IN(7)) xcd_barrier(bar); }
    if (IN(7) || IN(8)) {
        LAS int* tl = (LAS int*)(F.lds + LDS_TILEE_OFF); LAS int* ntl = (LAS int*)(F.lds + LDS_NTILES_OFF);
        __syncthreads();
        if (ovf) {
            const int nt = *(const int*)(ws + WS_MISC + M_NTILES);
            for (int i = F.tid; i < MAXTILES; i += NTHREADS) tl[i] = i | (((const int*)(ws + WS_MISC + M_TILEE))[i] << 11) | (256 << 16);
            if (F.tid == 0) ntl[0] = nt;
        } else {
            if (F.tid == 0) { int a = 0; for (int e = 0; e < NE; ++e) { ntl[1 + e] = a; a += ((int)((const unsigned*)(ws + WS_CTL))[CTL_CURSOR + e * CTL_CSTRIDE] + 255) >> 8; } ntl[0] = a; }
            __syncthreads();
            { const int e = F.tid >> 4; const int n = (int)((const unsigned*)(ws + WS_CTL))[CTL_CURSOR + e * CTL_CSTRIDE], nte = (n + 255) >> 8, b0 = ntl[1 + e];
              for (int v = F.tid & 15; v < nte; v += 16) { const int valid = (n - v * 256) < 256 ? (n - v * 256) : 256; tl[b0 + v] = (e * (ESTRIDE / 256) + v) | (e << 11) | (valid << 16); } }
        }
        __syncthreads();
    }
    if (IN(7)) {
        const int ntiles = __builtin_amdgcn_readfirstlane(*(const LAS int*)(F.lds + LDS_NTILES_OFF));
        constexpr int EB = MK_FP8 ? 1 : 2;
        pg8::MoeSched S; S.nunits = ntiles * 8; S.npn = 8; S.G = F.G; S.c = bid; S.A = (const char*)(ws + (MK_FP8 ? WS_H1B : WS_H1)); S.B = (const char*)(ws + WS_GUT); S.rows_ = (const int*)(ws + WS_SLOTTOK);
        S.tile_e = (const LAS int*)(F.lds + LDS_TILEE_OFF); S.a_tile = 0; S.e_bytes = (size_t)2 * DE * D * EB; S.pn_bytes = (size_t)256 * D * EB;
        EpiUp E{(const LAS int*)(F.lds + LDS_TILEE_OFF), (const float*)(ws + WS_SLOTRS), F.b_gu, (bf16_t*)(ws + WS_ACT)};
        int kq = D * EB / 2; asm volatile("" : "+s"(kq));
        pg8::gemm_phase<EpiUp, pg8::MoeSched, true, MK_ALIGN, MK_SP2, MK_FP8, false, true, MK_HALFU != 0, (MK_KROT & 16) != 0>(F.lds, kq, D * EB / 2, D * EB / 2, S, E);
    }
    SEAM(7);
    if (IN(8)) {
        const int ntiles = __builtin_amdgcn_readfirstlane(*(const LAS int*)(F.lds + LDS_NTILES_OFF));
        constexpr int EB = MK_FP8 ? 1 : 2;
        pg8::MoeSched S; S.nunits = ntiles * 4; S.npn = 4; S.G = F.G; S.c = bid; S.A = (const char*)(ws + WS_ACT); S.B = (const char*)(ws + WS_DNT); S.rows_ = nullptr;
        S.tile_e = (const LAS int*)(F.lds + LDS_TILEE_OFF); S.a_tile = (size_t)256 * DE * EB; S.e_bytes = (size_t)D * DE * EB; S.pn_bytes = (size_t)256 * DE * EB;
        EpiDown E{(const LAS int*)(F.lds + LDS_TILEE_OFF), (const float*)(ws + WS_SLOTGATE), F.b_dn, (bf16_t*)(ws + WS_YC)};
        int kq = DE * EB / 2; asm volatile("" : "+s"(kq));
        pg8::gemm_phase<EpiDown, pg8::MoeSched, false, MK_ALIGN, MK_SP2, MK_FP8, false, true, MK_HALFU != 0, (MK_KROT & 32) != 0>(F.lds, kq, DE * EB / 2, DE * EB / 2, S, E);
    }
    SEAM(8);
    if (IN(9)) p9_final(F);
#undef IN
#undef SEAM
}


extern "C" void kernel_launch(void* const* d_in, const int* in_sizes, int n_in, void* d_out, int out_size, void* d_ws, size_t ws_size, hipStream_t stream) {
    static int grid = 0;
    if (grid == 0) {
        if (n_in != 22 || out_size != NTOK * D || ws_size < WS_END) { fprintf(stderr, "kernel_launch: unexpected shapes (n_in %d out %d ws %zu)\n", n_in, out_size, ws_size); grid = -1; return; }
        int dev = 0, cus = 0, per_cu = 0;
        if (hipGetDevice(&dev) != hipSuccess || hipDeviceGetAttribute(&cus, hipDeviceAttributeMultiprocessorCount, dev) != hipSuccess) { grid = -1; return; }
        if (hipFuncSetAttribute((const void*)fwd_kernel, hipFuncAttributeMaxDynamicSharedMemorySize, LDS_BYTES) != hipSuccess) { fprintf(stderr, "kernel_launch: hipFuncSetAttribute failed\n"); grid = -1; return; }
        if (hipOccupancyMaxActiveBlocksPerMultiprocessor(&per_cu, (const void*)fwd_kernel, NTHREADS, LDS_BYTES) != hipSuccess || per_cu < 1) { fprintf(stderr, "kernel_launch: occupancy query says %d\n", per_cu); grid = -1; return; }
        grid = cus * 1;
    }
    if (grid < 0) return;
    if (hipMemsetAsync((char*)d_ws + WS_CTL, 0, 65536, stream) != hipSuccess) { fprintf(stderr, "kernel_launch: memset failed\n"); return; }
    Args a{};
    for (int i = 0; i < 22; ++i) a.in[i] = (const float*)d_in[i];
    a.out = (float*)d_out; a.ws = (unsigned char*)d_ws;
#ifndef MK_PROBE_LO
#define MK_PROBE_LO -1
#define MK_PROBE_HI -1
#endif
    const int cuts[4][2] = {{0, MK_PROBE_LO < 0 ? NPHASES : MK_PROBE_HI}, {MK_PROBE_LO, MK_PROBE_HI}, {MK_PROBE_HI, NPHASES}, {0, 0}};
    const int nl = MK_PROBE_LO < 0 ? 1 : (MK_PROBE_HI < NPHASES ? 3 : 2);
    for (int li = 0; li < nl; ++li) {
        a.ph_lo = cuts[li][0]; a.ph_hi = cuts[li][1]; a.bar_region = li;
        void* kargs[] = {&a};
        hipError_t e = hipLaunchCooperativeKernel((const void*)fwd_kernel, dim3(grid), dim3(NTHREADS), kargs, LDS_BYTES, stream);
        if (e != hipSuccess) fprintf(stderr, "cooperative launch failed: %s (grid %d)\n", hipGetErrorString(e), grid);
    }
}
```
